# Optimizing an MI355X kernel written in HIP

```python
import math
import jax, jax.numpy as jnp
from jax import lax
import numpy as np

D_MODEL = 1024
BATCH = 16
SEQ = 2048
DEPTH = 1

D_MIX = D_MODEL
D_CONV = D_MIX // 2
CONV_GROUPS = 8
CONV_WIDTH = 3
D_DELTA = D_MIX - D_CONV
DN_HEADS = 4
DN_HEAD_DIM = D_DELTA // DN_HEADS
DN_CONV_WIDTH = 4
DN_CHUNK = 64
N_GROUPS = 4
EXPERTS_PER_GROUP = 8
N_EXPERTS = N_GROUPS * EXPERTS_PER_GROUP
TOP_K = 2
D_EXPERT = D_MODEL // 4
MOE_BLOCK = 128
LN_EPS = 1e-5
RMS_EPS = 1e-6
DEEP_ALPHA = (2 * DEPTH) ** 0.25
DEEP_BETA = (8 * DEPTH) ** -0.25

IN_SPLITS = [D_CONV, D_CONV, D_CONV, 3 * D_DELTA, D_DELTA, DN_HEADS, DN_HEADS]
D_IN = sum(IN_SPLITS)

kernel_name = "hymba_conv_gdn_hiermoe_deepnorm_adaln"


def layer_norm(x, g, b):
    xf = x.astype(jnp.float32)
    mu = xf.mean(-1, keepdims=True)
    var = jnp.square(xf - mu).mean(-1, keepdims=True)
    return ((xf - mu) * lax.rsqrt(var + LN_EPS) * g + b).astype(x.dtype)


def rms_normalize(x):
    xf = x.astype(jnp.float32)
    return xf * lax.rsqrt(jnp.square(xf).mean(-1, keepdims=True) + RMS_EPS)


def l2_normalize(x):
    return x * lax.rsqrt(jnp.square(x).sum(-1, keepdims=True) + RMS_EPS)


def causal_depthwise_conv(x, w):
    K, C = w.shape
    return lax.conv_general_dilated(
        x, w[:, None, :].astype(x.dtype), window_strides=(1,), padding=[(K - 1, 0)],
        dimension_numbers=("NWC", "WIO", "NWC"), feature_group_count=C)


def short_conv_mixer(b_gate, c_gate, u, conv_w, norm_w):
    y = b_gate * causal_depthwise_conv(c_gate * u, conv_w)
    B_, L, _ = y.shape
    y = rms_normalize(y.reshape(B_, L, CONV_GROUPS, D_CONV // CONV_GROUPS)).reshape(B_, L, D_CONV)
    return (y * norm_w).astype(u.dtype)


def gated_delta_rule_chunked(q, k, v, g, beta):
    B_, H, L, dk = q.shape
    dv = v.shape[-1]
    C = DN_CHUNK
    N = L // C
    q = q.reshape(B_, H, N, C, dk)
    k = k.reshape(B_, H, N, C, dk)
    v = v.reshape(B_, H, N, C, dv)
    beta = beta.reshape(B_, H, N, C)
    g = jnp.cumsum(g.reshape(B_, H, N, C), axis=-1)
    idx = jnp.arange(C)
    lower_strict = idx[:, None] > idx[None, :]
    lower_incl = idx[:, None] >= idx[None, :]
    gamma = jnp.exp(jnp.where(lower_incl, g[..., :, None] - g[..., None, :], -jnp.inf))
    kk = jnp.einsum("bhncd,bhnsd->bhncs", k, k)
    l_mat = jnp.where(lower_strict, beta[..., :, None] * kk * gamma, 0.0)
    eye = jnp.eye(C, dtype=jnp.float32)
    rhs = jnp.concatenate([beta[..., None] * v, (beta * jnp.exp(g))[..., None] * k], axis=-1)
    sol = lax.linalg.triangular_solve(eye + l_mat, rhs, left_side=True, lower=True, unit_diagonal=True)
    u, w = sol[..., :dv], sol[..., dv:]
    qk = jnp.where(lower_incl, jnp.einsum("bhncd,bhnsd->bhncs", q, k) * gamma, 0.0)
    q_decay = q * jnp.exp(g)[..., None]
    k_to_end = k * jnp.exp(g[..., -1:] - g)[..., None]
    chunk_decay = jnp.exp(g[..., -1])

    def step(S, xs):
        u_c, w_c, qk_c, qd_c, ke_c, dec_c = xs
        delta = u_c - jnp.einsum("bhcd,bhde->bhce", w_c, S)
        o = jnp.einsum("bhcd,bhde->bhce", qd_c, S) + jnp.einsum("bhcs,bhse->bhce", qk_c, delta)
        S = S * dec_c[..., None, None] + jnp.einsum("bhcd,bhce->bhde", ke_c, delta)
        return S, o

    xs = tuple(jnp.moveaxis(a, 2, 0) for a in (u, w, qk, q_decay, k_to_end, chunk_decay))
    S0 = jnp.zeros((B_, H, dk, dv), jnp.float32)
    _, o = lax.scan(step, S0, xs)
    return jnp.moveaxis(o, 0, 2).reshape(B_, H, L, dv)


def gated_deltanet(qkv, z, beta_logit, a_logit, conv_w, A_log, dt_bias, norm_w):
    B_, L, _ = qkv.shape
    qkv = jax.nn.silu(causal_depthwise_conv(qkv, conv_w))
    q, k, v = jnp.split(qkv, 3, axis=-1)

    def heads(t):
        return t.reshape(B_, L, DN_HEADS, DN_HEAD_DIM).transpose(0, 2, 1, 3).astype(jnp.float32)

    qh = l2_normalize(heads(q)) * (DN_HEAD_DIM ** -0.5)
    kh = l2_normalize(heads(k))
    vh = heads(v)
    beta = jax.nn.sigmoid(beta_logit.astype(jnp.float32)).transpose(0, 2, 1)
    g = (-jnp.exp(A_log.astype(jnp.float32))
         * jax.nn.softplus(a_logit.astype(jnp.float32) + dt_bias.astype(jnp.float32))).transpose(0, 2, 1)
    o = gated_delta_rule_chunked(qh, kh, vh, g, beta).transpose(0, 2, 1, 3)
    zf = z.reshape(B_, L, DN_HEADS, DN_HEAD_DIM).astype(jnp.float32)
    o = rms_normalize(o) * norm_w * jax.nn.silu(zf)
    return o.reshape(B_, L, D_DELTA).astype(qkv.dtype)


def hierarchical_moe(h, w_grp, b_grp, w_exp, b_exp, w_gate, w_up, w_down):
    B_, L, D = h.shape
    T = B_ * L
    xf = h.reshape(T, D)
    grp_prob = jax.nn.softmax((xf @ w_grp).astype(jnp.float32) + b_grp, axis=-1)
    grp_w, grp_idx = lax.top_k(grp_prob, 1)
    exp_logits = ((xf @ w_exp).astype(jnp.float32) + b_exp).reshape(T, N_GROUPS, EXPERTS_PER_GROUP)
    exp_logits = jnp.take_along_axis(exp_logits, grp_idx[:, :, None], axis=1)[:, 0]
    top_p, top_i = lax.top_k(jax.nn.softmax(exp_logits, axis=-1), TOP_K)
    gate = grp_w * (top_p / top_p.sum(-1, keepdims=True))
    expert = grp_idx * EXPERTS_PER_GROUP + top_i
    A = T * TOP_K
    e_flat = expert.reshape(A)
    tok = jnp.repeat(jnp.arange(T), TOP_K)
    order = jnp.argsort(e_flat)
    e_sorted = e_flat[order]
    tok_sorted = tok[order]
    g_sorted = gate.reshape(A)[order]
    counts = jnp.bincount(e_flat, length=N_EXPERTS)
    padded = ((counts + MOE_BLOCK - 1) // MOE_BLOCK) * MOE_BLOCK
    start = jnp.cumsum(counts) - counts
    pend = jnp.cumsum(padded)
    pstart = pend - padded
    pos = pstart[e_sorted] + jnp.arange(A) - start[e_sorted]
    n_blocks = (A + MOE_BLOCK - 1) // MOE_BLOCK + N_EXPERTS
    n_rows = n_blocks * MOE_BLOCK
    x_rows = jnp.zeros((n_rows, D), h.dtype).at[pos].set(xf[tok_sorted])
    block_expert = jnp.minimum(
        jnp.searchsorted(pend, jnp.arange(n_blocks) * MOE_BLOCK, side="right"), N_EXPERTS - 1)

    def expert_block(args):
        xb, e = args
        hid = jax.nn.silu(xb @ w_gate[e]) * (xb @ w_up[e])
        return hid @ w_down[e]

    y_rows = lax.map(expert_block, (x_rows.reshape(n_blocks, MOE_BLOCK, D), block_expert)).reshape(n_rows, D)
    y = jnp.zeros((T, D), jnp.float32).at[tok_sorted].add(y_rows[pos].astype(jnp.float32) * g_sorted[:, None])
    return y.reshape(B_, L, D).astype(h.dtype)


def setup_inputs(seed: int = 0) -> dict:
    key = jax.random.key(seed)
    ks = jax.random.split(key, 24)
    f32 = jnp.float32
    nrm = lambda k, shape, s: jax.random.normal(k, shape, f32) * s
    dt = jnp.exp(jax.random.uniform(ks[10], (DEPTH, DN_HEADS), f32, math.log(1e-3), math.log(1e-1)))
    return {
        "x": nrm(ks[0], (BATCH, SEQ, D_MODEL), 1.0),
        "c": nrm(ks[1], (BATCH, D_MODEL), 1.0),
        "w_ada": nrm(ks[2], (DEPTH, D_MODEL, 6 * D_MODEL), D_MODEL ** -0.5),
        "b_ada": nrm(ks[3], (DEPTH, 6 * D_MODEL), 0.01),
        "w_in": nrm(ks[4], (DEPTH, D_MODEL, D_IN), D_MODEL ** -0.5),
        "conv_w": nrm(ks[5], (DEPTH, CONV_WIDTH, D_CONV), CONV_WIDTH ** -0.5),
        "conv_norm_w": 1.0 + nrm(ks[6], (DEPTH, D_CONV), 0.01),
        "dn_conv_w": nrm(ks[7], (DEPTH, DN_CONV_WIDTH, 3 * D_DELTA), DN_CONV_WIDTH ** -0.5),
        "dn_A_log": jnp.log(jax.random.uniform(ks[8], (DEPTH, DN_HEADS), f32, 1.0, 16.0)),
        "dn_dt_bias": dt + jnp.log(-jnp.expm1(-dt)),
        "dn_norm_w": 1.0 + nrm(ks[9], (DEPTH, DN_HEAD_DIM), 0.01),
        "w_out": nrm(ks[11], (DEPTH, D_MIX, D_MODEL), D_MIX ** -0.5 * DEEP_BETA),
        "ln1_g": 1.0 + nrm(ks[12], (DEPTH, D_MODEL), 0.01),
        "ln1_b": nrm(ks[13], (DEPTH, D_MODEL), 0.01),
        "w_grp": nrm(ks[14], (DEPTH, D_MODEL, N_GROUPS), D_MODEL ** -0.5),
        "b_grp": nrm(ks[15], (DEPTH, N_GROUPS), 0.01),
        "w_exp": nrm(ks[16], (DEPTH, D_MODEL, N_EXPERTS), D_MODEL ** -0.5),
        "b_exp": nrm(ks[17], (DEPTH, N_EXPERTS), 0.01),
        "w_gate": nrm(ks[18], (DEPTH, N_EXPERTS, D_MODEL, D_EXPERT), D_MODEL ** -0.5),
        "w_up": nrm(ks[19], (DEPTH, N_EXPERTS, D_MODEL, D_EXPERT), D_MODEL ** -0.5),
        "w_down": nrm(ks[20], (DEPTH, N_EXPERTS, D_EXPERT, D_MODEL), D_EXPERT ** -0.5 * DEEP_BETA),
        "ln2_g": 1.0 + nrm(ks[21], (DEPTH, D_MODEL), 0.01),
        "ln2_b": nrm(ks[22], (DEPTH, D_MODEL), 0.01),
    }


def reference(x, c, w_ada, b_ada, w_in, conv_w, conv_norm_w, dn_conv_w, dn_A_log, dn_dt_bias, dn_norm_w,
              w_out, ln1_g, ln1_b, w_grp, b_grp, w_exp, b_exp, w_gate, w_up, w_down, ln2_g, ln2_b):
    split_at = [int(i) for i in np.cumsum(IN_SPLITS)[:-1]]
    c_act = jax.nn.silu(c)
    for l in range(DEPTH):
        mod = c_act @ w_ada[l] + b_ada[l]
        shift1, scale1, gate1, shift2, scale2, gate2 = [m[:, None, :] for m in jnp.split(mod, 6, axis=-1)]
        h = x * (1.0 + scale1) + shift1
        proj = h @ w_in[l]
        b_gate, c_gate, u, qkv, z, beta_logit, a_logit = jnp.split(proj, split_at, axis=-1)
        y_conv = short_conv_mixer(b_gate, c_gate, u, conv_w[l], conv_norm_w[l])
        y_dn = gated_deltanet(qkv, z, beta_logit, a_logit, dn_conv_w[l], dn_A_log[l], dn_dt_bias[l], dn_norm_w[l])
        mix = jnp.concatenate([y_conv, y_dn], axis=-1) @ w_out[l]
        x = layer_norm(DEEP_ALPHA * x + gate1 * mix, ln1_g[l], ln1_b[l])
        h = x * (1.0 + scale2) + shift2
        ffn = hierarchical_moe(h, w_grp[l], b_grp[l], w_exp[l], b_exp[l], w_gate[l], w_up[l], w_down[l])
        x = layer_norm(DEEP_ALPHA * x + gate2 * ffn, ln2_g[l], ln2_b[l])
    return x
```

```cpp
#include <hip/hip_runtime.h>
#include <cstdio>
#include <cstdint>
#include <utility>

#ifndef LEVEL
#define LEVEL 4
#endif
#ifndef MK_ONE_LAUNCH
#define MK_ONE_LAUNCH 1
#endif

#define GAS __attribute__((address_space(1)))
#define LAS __attribute__((address_space(3)))
typedef unsigned short bf16;
typedef unsigned v4u __attribute__((ext_vector_type(4)));
typedef unsigned v2u __attribute__((ext_vector_type(2)));
typedef float f32x4 __attribute__((ext_vector_type(4)));
typedef float f32x2 __attribute__((ext_vector_type(2)));
typedef short bf16x8 __attribute__((ext_vector_type(8)));
typedef GAS unsigned gu32;
#define RLX_AGENT __ATOMIC_RELAXED, __HIP_MEMORY_SCOPE_AGENT
#define LDS_WAIT() asm volatile("s_waitcnt lgkmcnt(0)" ::: "memory")
#define VM_WAIT() asm volatile("s_waitcnt vmcnt(0)" ::: "memory")

constexpr int NWAVES = 8, NTHR = 512;
constexpr int NB = 16, SEQ = 2048, D = 1024, T = NB * SEQ;
constexpr int DIN = 3592, NMAIN = 3584;
constexpr int DC = 512, CONVG = 64;
constexpr int NH = 4, HD = 128, DD = 512;
constexpr int CHK = 64, NCHUNK = SEQ / CHK, NCHUNK_ALL = NB * NH * NCHUNK;
constexpr int NE = 32, EPG = 8, NG = 4, DE = 256;
constexpr float LN_EPS = 1e-5f, RMS_EPS = 1e-6f;
constexpr float ALPHA = 1.18920711500272f;
constexpr int MAXROWS = T * 2 + NE * 256;

constexpr size_t MiB = 1u << 20;
constexpr size_t WS_CTL = 0, CTL_ZERO_BYTES = 1 * MiB;
constexpr size_t WS_MOD = 1 * MiB;
constexpr size_t WS_BA = 1 * MiB + 512 * 1024;
constexpr size_t WS_TOKE = 3 * MiB, WS_TOKR = 3 * MiB + 256 * 1024, WS_TOKG = 3 * MiB + 512 * 1024, WS_DEC = 3 * MiB + 768 * 1024;
constexpr size_t WS_ELIST = 4 * MiB;
constexpr size_t WS_WIN = 12 * MiB, WS_WOUT = 19 * MiB, WS_WGU = 21 * MiB, WS_WD = 53 * MiB;
constexpr size_t WS_R1 = 72 * MiB;
constexpr size_t WS_PBCU = 136 * MiB, WS_PQKV = 232 * MiB, WS_PZ = 328 * MiB;
constexpr size_t WS_DNW = 360 * MiB, WS_DNQ = 392 * MiB, WS_DNK = 424 * MiB, WS_DNG = 456 * MiB, WS_DNU = 472 * MiB;
constexpr size_t WS_MIX = 136 * MiB, WS_X1 = 232 * MiB, WS_HID = 136 * MiB, WS_YR = 360 * MiB;
constexpr size_t WS_END = 504 * MiB;
constexpr int CW_CNT = 64;
constexpr int CW_BAR = 4096;

constexpr int RING_OFF = 0, RING_BYTES = 131072;
constexpr int XTOK_OFF = 131072;
constexpr int LDSCTL_OFF = 147456, MISC_OFF = LDSCTL_OFF + 1024;
constexpr int LDS_BYTES = 155648;

__device__ __forceinline__ unsigned f2bf(float f) { unsigned u = __builtin_bit_cast(unsigned, f); return (u + 0x7fffu + ((u >> 16) & 1u)) >> 16; }
__device__ __forceinline__ unsigned pk2(float lo, float hi) { return f2bf(lo) | (f2bf(hi) << 16); }
__device__ __forceinline__ float bflo(unsigned w) { return __builtin_bit_cast(float, w << 16); }
__device__ __forceinline__ float bfhi(unsigned w) { return __builtin_bit_cast(float, w & 0xffff0000u); }
__device__ __forceinline__ float bf1(bf16 b) { return __builtin_bit_cast(float, ((unsigned)b) << 16); }
__device__ __forceinline__ float wave_sum(float v) {
#pragma unroll
    for (int o = 1; o < 64; o <<= 1) v += __shfl_xor(v, o);
    return v;
}
__device__ __forceinline__ float siluf(float x) { return x / (1.f + __expf(-x)); }

namespace pg8 {
#define PG8_LAS __attribute__((address_space(3)))
typedef unsigned short bf16_t;
typedef unsigned u32x4 __attribute__((ext_vector_type(4)));
constexpr int BM = 256, BK = 64, HALF = 128, HTB = HALF * BK * 2, STAGE_BYTES = 8 * HTB;

__host__ __device__ __forceinline__ int lds_byte(int r, int c) { const int st = (r >> 4) * 2 + (c >> 5), rr = r & 15, cc = c & 31, ob = rr * 64 + cc * 2; return st * 1024 + (ob ^ (((ob >> 9) & 1) << 5)); }
__host__ __device__ __forceinline__ void stage_rc(int b, int& R, int& C) { const int st = b / 1024, sb = b % 1024, swz = sb ^ (((sb >> 9) & 1) << 5); R = (st >> 1) * 16 + swz / 64; C = (st & 1) * 32 + (swz % 64) / 2; }
__host__ __device__ __forceinline__ int perm32(int rho) { const int n = rho >> 4, i = rho & 15; return 8 * (i >> 2) + 4 * n + (i & 3); }

struct Unit { const char* a; const char* b; int i0, i1, i2; };

__device__ __forceinline__ unsigned cvt_pk_bf16(float lo, float hi) { unsigned r; asm volatile("v_cvt_pk_bf16_f32 %0, %1, %2" : "=v"(r) : "v"(lo), "v"(hi)); return r; }

template <class Epi, class Sched, bool ALIGN_EPI = false, bool SP2 = true>
__device__ __forceinline__ void gemm_phase(PG8_LAS unsigned char* lds, const int K, const Sched& S, const Epi& E) {
    const int tid = threadIdx.x, wid = __builtin_amdgcn_readfirstlane(tid >> 6), lane = tid & 63, wr = wid >> 2, wc = wid & 3, fr = lane & 15, fq = lane >> 4;
    const int nt = K / BK;
    int R[2], C[2];
    unsigned voffA[2][2], nvoffA[2][2], voffB[2];
#pragma unroll
    for (int i = 0; i < 2; ++i) { stage_rc(tid * 16 + i * 8192, R[i], C[i]); const int Rb = Epi::PERM ? ((R[i] & ~31) + perm32(R[i] & 31)) : R[i];
        voffB[i] = (unsigned)(Rb * K + C[i]) * 2u; }
    const size_t kstep = (size_t)(BK * 2);
    const size_t hstep = (size_t)HALF * K * 2;
    const unsigned ldsw = (unsigned)wid * 1024u;
    const int aoff = lds_byte(wr * 64 + fr, fq * 8), boff = lds_byte(wc * 32 + fr, fq * 8);
#define PG8_SA(b, h) (((b) * 2 + (h)) * HTB)
#define PG8_SB(b, h) ((4 + (b) * 2 + (h)) * HTB)
#define PG8_STAGEB(bufoff, gbase) do { _Pragma("unroll") for (int _i = 0; _i < 2; ++_i) \
        __builtin_amdgcn_global_load_lds((const unsigned*)((const char*)(gbase) + voffB[_i]), (PG8_LAS unsigned*)(lds + (bufoff) + ldsw + _i * 8192), 16, 0, 0); } while (0)
#define PG8_STAGEA(bufoff, gbase, vo, h) do { _Pragma("unroll") for (int _i = 0; _i < 2; ++_i) \
        __builtin_amdgcn_global_load_lds((const unsigned*)((const char*)(gbase) + (vo)[h][_i]), (PG8_LAS unsigned*)(lds + (bufoff) + ldsw + _i * 8192), 16, 0, 0); } while (0)
#define PG8_LDA(dst, b, h) do { _Pragma("unroll") for (int m = 0; m < 4; ++m) _Pragma("unroll") for (int k = 0; k < 2; ++k) dst[m][k] = *(const PG8_LAS bf16x8*)(lds + PG8_SA(b, h) + aoff + m * 2048 + k * 1024); } while (0)
#define PG8_LDB(dst, b, h) do { _Pragma("unroll") for (int n = 0; n < 2; ++n) _Pragma("unroll") for (int k = 0; k < 2; ++k) dst[n][k] = *(const PG8_LAS bf16x8*)(lds + PG8_SB(b, h) + boff + n * 2048 + k * 1024); } while (0)
#define PG8_MMA(ai, bj, At, Bt) do { __builtin_amdgcn_s_setprio(1); _Pragma("unroll") for (int m = 0; m < 4; ++m) _Pragma("unroll") for (int n = 0; n < 2; ++n) _Pragma("unroll") for (int k = 0; k < 2; ++k) \
        acc[ai][bj][m][n] = __builtin_amdgcn_mfma_f32_16x16x32_bf16(Bt[n][k], At[m][k], acc[ai][bj][m][n], 0, 0, 0); __builtin_amdgcn_s_setprio(0); } while (0)
#define PG8_WAIT_V(n) asm volatile("s_waitcnt vmcnt(" #n ")" ::: "memory")
#define PG8_WAIT_L(n) asm volatile("s_waitcnt lgkmcnt(" #n ")" ::: "memory")
#define PG8_BAR __builtin_amdgcn_s_barrier()
#define PG8_SCHED __builtin_amdgcn_sched_barrier(0)
    Unit cur, nxt; int ui = 0;
    if (!S.next(0, cur)) return;
    S.a_off(cur, 0, voffA, R, C, K);
    f32x4 acc[2][2][4][2];
#pragma unroll
    for (int a = 0; a < 2; ++a)
#pragma unroll
        for (int b = 0; b < 2; ++b)
#pragma unroll
            for (int m = 0; m < 4; ++m)
#pragma unroll
                for (int n = 0; n < 2; ++n) acc[a][b][m][n] = (f32x4){0.f, 0.f, 0.f, 0.f};
    bf16x8 At[4][2], B0[2][2], B1[2][2];
    const char* cA = cur.a; const char* cB = cur.b;
    static_assert(SP2, "only the SP2 loop is kept in this file");
    PG8_STAGEB(PG8_SB(0, 0), cB); PG8_STAGEB(PG8_SB(0, 1), cB + hstep); PG8_STAGEA(PG8_SA(0, 0), cA, voffA, 0); PG8_STAGEA(PG8_SA(0, 1), cA, voffA, 1);
    if (wr == 1) PG8_BAR;
    PG8_WAIT_V(2); PG8_BAR;
    PG8_STAGEB(PG8_SB(1, 0), cB + kstep); PG8_STAGEA(PG8_SA(1, 0), cA + kstep, voffA, 0); PG8_STAGEB(PG8_SB(1, 1), cB + hstep + kstep);
    PG8_WAIT_V(6); PG8_BAR;
    for (;;) {
        const bool has_next = S.next(ui + 1, nxt);
        const char* nA = has_next ? nxt.a : cA; const char* nB = has_next ? nxt.b : cB;
        if (Sched::GATHER && has_next) S.a_off(nxt, ui + 1, nvoffA, R, C, K);
        else {
#pragma unroll
            for (int h = 0; h < 2; ++h)
#pragma unroll
                for (int i = 0; i < 2; ++i) nvoffA[h][i] = voffA[h][i]; }
        for (int t = 0; t < nt; t += 2) {
            const bool last = (t == nt - 2);
            const char* a1 = cA + (size_t)(t + 1) * kstep;
            const char* a2 = last ? nA : cA + (size_t)(t + 2) * kstep; const char* b2 = last ? nB : cB + (size_t)(t + 2) * kstep;
            const char* a3 = a2 + kstep; const char* b3 = b2 + kstep;
            unsigned va2[2][2];
#pragma unroll
            for (int h = 0; h < 2; ++h)
#pragma unroll
                for (int i = 0; i < 2; ++i) va2[h][i] = (Sched::GATHER && last) ? nvoffA[h][i] : voffA[h][i];
            PG8_LDB(B0, 0, 0); PG8_LDB(B1, 0, 1); PG8_SCHED; PG8_LDA(At, 0, 0); PG8_STAGEA(PG8_SA(1, 1), a1, voffA, 1);
            PG8_WAIT_V(8); PG8_WAIT_L(0); PG8_BAR; PG8_MMA(0, 0, At, B0); PG8_MMA(0, 1, At, B1); PG8_BAR; PG8_SCHED;
            PG8_LDA(At, 0, 1); PG8_STAGEB(PG8_SB(0, 0), b2); PG8_STAGEB(PG8_SB(0, 1), b2 + hstep); PG8_STAGEA(PG8_SA(0, 0), a2, va2, 0);
            PG8_WAIT_V(8); PG8_WAIT_L(0); PG8_BAR; PG8_MMA(1, 0, At, B0); PG8_MMA(1, 1, At, B1); PG8_BAR; PG8_SCHED;
            PG8_LDB(B0, 1, 0); PG8_LDB(B1, 1, 1); PG8_SCHED; PG8_LDA(At, 1, 0); PG8_STAGEA(PG8_SA(0, 1), a2, va2, 1);
            PG8_WAIT_V(8); PG8_WAIT_L(0); PG8_BAR; PG8_MMA(0, 0, At, B0); PG8_MMA(0, 1, At, B1); PG8_BAR; PG8_SCHED;
            PG8_LDA(At, 1, 1); PG8_STAGEB(PG8_SB(1, 0), b3); PG8_STAGEB(PG8_SB(1, 1), b3 + hstep); PG8_STAGEA(PG8_SA(1, 0), a3, va2, 0);
            PG8_WAIT_V(8); PG8_WAIT_L(0); PG8_BAR; PG8_MMA(1, 0, At, B0); PG8_MMA(1, 1, At, B1); PG8_BAR; PG8_SCHED;
        }
        if constexpr (ALIGN_EPI) { if (wr == 0) PG8_BAR; }
        E(acc, cur, wr, wc, fr, fq);
        if (!has_next) break;
#pragma unroll
        for (int a = 0; a < 2; ++a)
#pragma unroll
            for (int b = 0; b < 2; ++b)
#pragma unroll
                for (int m = 0; m < 4; ++m)
#pragma unroll
                    for (int n = 0; n < 2; ++n) acc[a][b][m][n] = (f32x4){0.f, 0.f, 0.f, 0.f};
        cur = nxt; cA = nA; cB = nB; ++ui;
#pragma unroll
        for (int h = 0; h < 2; ++h)
#pragma unroll
            for (int i = 0; i < 2; ++i) voffA[h][i] = nvoffA[h][i];
        if constexpr (ALIGN_EPI) { if (wr == 1) PG8_BAR; }
    }
    PG8_WAIT_V(0);
    if constexpr (!ALIGN_EPI) { if (wr == 0) PG8_BAR; }
    PG8_BAR;
#undef PG8_SA
#undef PG8_SB
#undef PG8_STAGEA
#undef PG8_STAGEB
#undef PG8_LDA
#undef PG8_LDB
#undef PG8_MMA
#undef PG8_WAIT_V
#undef PG8_WAIT_L
#undef PG8_BAR
#undef PG8_SCHED
}

struct DenseOrder {
    static constexpr bool GATHER = false;
    const char* A; const char* Bt; int nM, nN, nwg, G, c, K;
    __device__ void init(const void* A_, const void* Bt_, int M, int N, int K_, int G_, int c_) { A = (const char*)A_; Bt = (const char*)Bt_; nM = M / BM; nN = N / BM; nwg = nM * nN; G = G_; c = c_; K = K_; }
    __device__ __forceinline__ bool next(int i, Unit& u) const {
        const long L = (long)i * G + c; if (L >= nwg) return false;
        int wgid = (int)L; { const int q = nwg / 8, r = nwg % 8, xcd = wgid % 8, off = wgid / 8; wgid = (xcd < r ? xcd * (q + 1) : r * (q + 1) + (xcd - r) * q) + off; }
        const int nig = 8 * nN, gid = wgid / nig, fm = gid * 8, gsz = (nM - fm) < 8 ? (nM - fm) : 8;
        const int pm = fm + ((wgid % nig) % gsz), pn = (wgid % nig) / gsz;
        u.a = A + (size_t)pm * BM * K * 2; u.b = Bt + (size_t)pn * BM * K * 2; u.i0 = pm; u.i1 = pn; u.i2 = 0; return true;
    }
    __device__ __forceinline__ void a_off(const Unit&, int, unsigned (&vo)[2][2], const int (&R)[2], const int (&C)[2], int K_) const {
#pragma unroll
        for (int h = 0; h < 2; ++h)
#pragma unroll
            for (int i = 0; i < 2; ++i) vo[h][i] = (unsigned)((h * HALF + R[i]) * K_ + C[i]) * 2u;
    }
};
}

#define XB_TMO      128
#define XB_XCNT(j)  (256  + 64 * (j))
#define XB_XSUB(j)  (1280 + 64 * (j))
#define XB_XGEN(j)  (2304 + 64 * (j))
#define XB_TOP      3328
#define XB_TOPGEN   3392
#define XCD_BAR_WORDS 3456
#define XB_SPIN_CAP (1u << 18)
__device__ __forceinline__ unsigned xb_ld(unsigned* p)              { return __hip_atomic_load(p, __ATOMIC_RELAXED, __HIP_MEMORY_SCOPE_AGENT); }
__device__ __forceinline__ unsigned xb_add(unsigned* p, unsigned v) { return __hip_atomic_fetch_add(p, v, __ATOMIC_RELAXED, __HIP_MEMORY_SCOPE_AGENT); }
__device__ __forceinline__ unsigned xb_xcc_id() { return (unsigned)__builtin_amdgcn_s_getreg((3 << 11) | 20) & 0xFu; }
#define XB_SPIN(cond, bar) do { unsigned _sp = 0; while (cond) { __builtin_amdgcn_s_sleep(1); \
    if ((++_sp & 255u) == 0u) { if (xb_ld(&(bar)[XB_TMO])) break; if (_sp > XB_SPIN_CAP) { atomicAdd(&(bar)[XB_TMO], 1u); break; } } } } while (0)
struct XcdBarrier { unsigned* bar; unsigned x; volatile LAS unsigned* st; };
__device__ __forceinline__ XcdBarrier xcd_barrier_post(unsigned* bar, volatile LAS unsigned* st) {
    XcdBarrier b; b.bar = bar; b.x = xb_xcc_id(); b.st = st;
    if (threadIdx.x == 0) (void)xb_add(&bar[XB_XCNT(b.x)], 1u);
    return b;
}
__device__ __forceinline__ void xcd_barrier_complete(unsigned* bar, unsigned x, unsigned& nloc, unsigned& nx) {
    const unsigned G = gridDim.x * gridDim.y * gridDim.z;
    unsigned sum, cnt, mine, sp = 0u;
    for (;;) {
        sum = 0u; cnt = 0u; mine = 0u;
#pragma unroll
        for (unsigned j = 0; j < 16; ++j) { const unsigned c = xb_ld(&bar[XB_XCNT(j)]); sum += c; cnt += (c > 0u) ? 1u : 0u; mine = (j == x) ? c : mine; }
        if (sum == G) break;
        __builtin_amdgcn_s_sleep(1);
        if ((++sp & 255u) == 0u) { if (xb_ld(&bar[XB_TMO])) break; if (sp > XB_SPIN_CAP) { atomicAdd(&bar[XB_TMO], 1u); break; } }
    }
    nloc = mine > 0u ? mine : 1u; nx = cnt > 0u ? cnt : 1u;
}
__device__ __forceinline__ void xcd_barrier(const XcdBarrier& b) {
    asm volatile("s_waitcnt vmcnt(0)" ::: "memory");
    __syncthreads();
    if (threadIdx.x == 0) {
        unsigned* bar = b.bar;
        __builtin_amdgcn_s_waitcnt(0);
        unsigned nloc = b.st[0], nx = b.st[1];
        if (nloc == 0u) { xcd_barrier_complete(bar, b.x, nloc, nx); b.st[0] = nloc; b.st[1] = nx; }
        const unsigned old = xb_add(&bar[XB_XSUB(b.x)], 1u);
        const unsigned gen = old / nloc;
        if (old + 1u == (gen + 1u) * nloc) {
            __builtin_amdgcn_fence(__ATOMIC_RELEASE, "agent");
            asm volatile("s_waitcnt vmcnt(0)" ::: "memory");
            const unsigned og = xb_add(&bar[XB_TOP], 1u);
            const unsigned tg = og / nx;
            if (og + 1u == (tg + 1u) * nx) xb_add(&bar[XB_TOPGEN], 1u);
            else XB_SPIN(xb_ld(&bar[XB_TOPGEN]) == tg, bar);
            __builtin_amdgcn_fence(__ATOMIC_ACQUIRE, "agent");
            xb_add(&bar[XB_XGEN(b.x)], 1u);
            asm volatile("s_waitcnt vmcnt(0)" ::: "memory");
        } else {
            XB_SPIN(xb_ld(&bar[XB_XGEN(b.x)]) == gen, bar);
            __builtin_amdgcn_fence(__ATOMIC_ACQUIRE, "agent");
            asm volatile("s_waitcnt vmcnt(0)" ::: "memory");
        }
    }
    __syncthreads();
}

struct Frame {
    LAS unsigned char* lds;
    int tid, lane, wave, vcu, G;
    const float *x, *c, *w_ada, *b_ada, *w_in, *conv_w, *conv_norm_w, *dn_conv_w, *dn_A_log, *dn_dt_bias, *dn_norm_w, *w_out, *ln1_g, *ln1_b,
                *w_grp, *b_grp, *w_exp, *b_exp, *w_gate, *w_up, *w_down, *ln2_g, *ln2_b;
    float* out; unsigned char* ws;
};

__device__ __forceinline__ void transpose_item(const float* W, int ldw, int k0, int n0, bf16* WT, int ldt, int drow0, LAS float* scr, int lane) {
#pragma unroll 8
    for (int i = 0; i < 32; ++i) { const int kk = 2 * i + (lane >> 5); scr[kk * 33 + (lane & 31)] = W[(size_t)(k0 + kk) * ldw + n0 + (lane & 31)]; }
    LDS_WAIT(); asm volatile("" ::: "memory");
    const int c = lane & 7;
#pragma unroll
    for (int j = 0; j < 4; ++j) { const int n = (lane >> 3) + 8 * j; const LAS float* s = scr + (8 * c) * 33 + n;
        v4u o; o.x = pk2(s[0 * 33], s[1 * 33]); o.y = pk2(s[2 * 33], s[3 * 33]); o.z = pk2(s[4 * 33], s[5 * 33]); o.w = pk2(s[6 * 33], s[7 * 33]);
        *(GAS v4u*)(WT + (size_t)(drow0 + n) * ldt + k0 + 8 * c) = o; }
    LDS_WAIT(); asm volatile("" ::: "memory");
}
__device__ __forceinline__ void p0_prologue(Frame& F) {
    if (blockIdx.x < 96) {
        LAS float* sc = (LAS float*)(F.lds);
        LAS float* red = (LAS float*)(F.lds + 65536);
        for (int idx = F.tid; idx < 16 * 1024; idx += NTHR) { const int b = idx >> 10, k = idx & 1023; sc[k * 16 + b] = siluf(F.c[idx]); }
        __syncthreads();
        const int col = blockIdx.x * 64 + F.lane, kbeg = F.wave * 128;
        float acc[16];
#pragma unroll
        for (int b = 0; b < 16; ++b) acc[b] = 0.f;
#pragma unroll 4
        for (int k = kbeg; k < kbeg + 128; ++k) {
            const float w = F.w_ada[(size_t)k * 6144 + col];
            const LAS f32x4* s4 = (const LAS f32x4*)(sc + k * 16);
#pragma unroll
            for (int q = 0; q < 4; ++q) { const f32x4 s = s4[q]; acc[4 * q] += s.x * w; acc[4 * q + 1] += s.y * w; acc[4 * q + 2] += s.z * w; acc[4 * q + 3] += s.w * w; }
        }
#pragma unroll
        for (int b = 0; b < 16; ++b) red[(F.wave * 16 + b) * 64 + F.lane] = acc[b];
        __syncthreads();
        for (int o = F.tid; o < 1024; o += NTHR) { const int b = o >> 6, l = o & 63; float s = 0.f;
#pragma unroll
            for (int w = 0; w < 8; ++w) s += red[(w * 16 + b) * 64 + l];
            const int cc = blockIdx.x * 64 + l;
            ((float*)(F.ws + WS_MOD))[b * 6144 + cc] = s + F.b_ada[cc]; }
        __syncthreads();
    }
    LAS float* scr = (LAS float*)(F.lds + F.wave * 16384);
    const int gw = F.vcu * NWAVES + F.wave, NGW = F.G * NWAVES;
    constexpr int I_IN = 16 * (NMAIN / 32), I_OUT = 16 * 32, I_G = NE * 16 * 8, I_D = NE * 4 * 32;
    constexpr int NITEMS = I_IN + I_OUT + 2 * I_G + I_D;
    bf16* WIN = (bf16*)(F.ws + WS_WIN); bf16* WOUT = (bf16*)(F.ws + WS_WOUT); bf16* WGU = (bf16*)(F.ws + WS_WGU); bf16* WD = (bf16*)(F.ws + WS_WD);
    for (int it = gw; it < NITEMS; it += NGW) {
        int r = it;
        if (r < I_IN) { const int kb = r / (NMAIN / 32), nb = r % (NMAIN / 32); transpose_item(F.w_in, DIN, 64 * kb, 32 * nb, WIN, D, 32 * nb, scr, F.lane); continue; } r -= I_IN;
        if (r < I_OUT) { const int kb = r / 32, nb = r % 32; transpose_item(F.w_out, D, 64 * kb, 32 * nb, WOUT, D, 32 * nb, scr, F.lane); continue; } r -= I_OUT;
        if (r < 2 * I_G) { const int up = r / I_G; r -= up * I_G; const int e = r / 128, kb = (r % 128) / 8, nb = r % 8, n0 = 32 * nb;
            transpose_item((up ? F.w_up : F.w_gate) + (size_t)e * D * DE, DE, 64 * kb, n0, WGU + (size_t)e * 512 * D, D, (n0 / 128) * 256 + up * 128 + (n0 % 128), scr, F.lane); continue; } r -= 2 * I_G;
        { const int e = r / 128, kb = (r % 128) / 32, nb = r % 32; transpose_item(F.w_down + (size_t)e * DE * D, D, 64 * kb, 32 * nb, WD + (size_t)e * D * DE, DE, 32 * nb, scr, F.lane); }
    }
}

__device__ __forceinline__ void p1_modulate(Frame& F) {
    LAS float* wx = (LAS float*)(F.lds);
    for (int idx = F.tid; idx < 8192; idx += NTHR) { const int k = idx >> 3, o = idx & 7, j = k >> 8, l = (k >> 2) & 63, e = k & 3;
        wx[(((o >> 2) * 16 + (j * 4 + e)) * 64 + l) * 4 + (o & 3)] = F.w_in[(size_t)k * DIN + NMAIN + o]; }
    __syncthreads();
    const float* MOD = (const float*)(F.ws + WS_MOD);
    bf16* H1 = (bf16*)(F.ws + WS_R1); float* BA = (float*)(F.ws + WS_BA);
    for (int gw = F.vcu * NWAVES + F.wave; gw < T / 16; gw += F.G * NWAVES) {
    const int m0 = gw * 16, b = m0 >> 11;
    f32x4 sc[4], sh[4];
#pragma unroll
    for (int j = 0; j < 4; ++j) { sh[j] = *(const f32x4*)(MOD + b * 6144 + 256 * j + 4 * F.lane); sc[j] = *(const f32x4*)(MOD + b * 6144 + D + 256 * j + 4 * F.lane); }
    for (int r = 0; r < 16; ++r) {
        const int m = m0 + r;
        const GAS f32x4* xr = (const GAS f32x4*)(F.x + (size_t)m * D) + F.lane;
        f32x4 h[4];
#pragma unroll
        for (int j = 0; j < 4; ++j) { const f32x4 v = xr[64 * j]; h[j] = v * (sc[j] + 1.0f) + sh[j]; }
        GAS unsigned long long* o8 = (GAS unsigned long long*)(H1 + (size_t)m * D) + F.lane;
#pragma unroll
        for (int j = 0; j < 4; ++j) o8[64 * j] = (unsigned long long)pk2(h[j].x, h[j].y) | ((unsigned long long)pk2(h[j].z, h[j].w) << 32);
        float a[8];
#pragma unroll
        for (int o = 0; o < 8; ++o) a[o] = 0.f;
#pragma unroll
        for (int j = 0; j < 4; ++j)
#pragma unroll
            for (int e = 0; e < 4; ++e) { const float hv = h[j][e];
                const f32x4 w0 = *(const LAS f32x4*)(wx + ((0 * 16 + (j * 4 + e)) * 64 + F.lane) * 4), w1 = *(const LAS f32x4*)(wx + ((1 * 16 + (j * 4 + e)) * 64 + F.lane) * 4);
                a[0] += hv * w0.x; a[1] += hv * w0.y; a[2] += hv * w0.z; a[3] += hv * w0.w; a[4] += hv * w1.x; a[5] += hv * w1.y; a[6] += hv * w1.z; a[7] += hv * w1.w; }
#pragma unroll
        for (int o = 0; o < 8; ++o) a[o] = wave_sum(a[o]);
        if (F.lane == 0) { *(f32x4*)(BA + (size_t)m * 8) = (f32x4){a[0], a[1], a[2], a[3]}; *(f32x4*)(BA + (size_t)m * 8 + 4) = (f32x4){a[4], a[5], a[6], a[7]}; }
    }
    }
}

struct EpiP {
    static constexpr bool PERM = true;
    unsigned char* ws;
    __device__ __forceinline__ void operator()(const f32x4 (&acc)[2][2][4][2], const pg8::Unit& u, int wr, int wc, int fr, int fq) const {
        const int pm = u.i0, pn = u.i1;
        bf16* base; int ldc, colt;
        if (pn < 6) { base = (bf16*)(ws + WS_PBCU); ldc = 1536; colt = pn * 256; }
        else if (pn < 12) { base = (bf16*)(ws + WS_PQKV); ldc = 1536; colt = (pn - 6) * 256; }
        else { base = (bf16*)(ws + WS_PZ); ldc = 512; colt = (pn - 12) * 256; }
        const int row0 = pm * 256 + wr * 64 + fr, col0 = colt + wc * 32 + 8 * fq;
#pragma unroll
        for (int ai = 0; ai < 2; ++ai)
#pragma unroll
            for (int m = 0; m < 4; ++m) { bf16* rowp = base + (size_t)(row0 + ai * 128 + m * 16) * ldc + col0;
#pragma unroll
                for (int bj = 0; bj < 2; ++bj) { const f32x4 v0 = acc[ai][bj][m][0], v1 = acc[ai][bj][m][1];
                    v4u w; w.x = pg8::cvt_pk_bf16(v0[0], v0[1]); w.y = pg8::cvt_pk_bf16(v0[2], v0[3]); w.z = pg8::cvt_pk_bf16(v1[0], v1[1]); w.w = pg8::cvt_pk_bf16(v1[2], v1[3]);
                    *(v4u*)(rowp + bj * 128) = w; } }
    }
};
struct EpiBf {
    static constexpr bool PERM = true;
    bf16* O; int ldc;
    __device__ __forceinline__ void operator()(const f32x4 (&acc)[2][2][4][2], const pg8::Unit& u, int wr, int wc, int fr, int fq) const {
        const int row0 = u.i0 * 256 + wr * 64 + fr, col0 = u.i1 * 256 + wc * 32 + 8 * fq;
#pragma unroll
        for (int ai = 0; ai < 2; ++ai)
#pragma unroll
            for (int m = 0; m < 4; ++m) { bf16* rowp = O + (size_t)(row0 + ai * 128 + m * 16) * ldc + col0;
#pragma unroll
                for (int bj = 0; bj < 2; ++bj) { const f32x4 v0 = acc[ai][bj][m][0], v1 = acc[ai][bj][m][1];
                    v4u w; w.x = pg8::cvt_pk_bf16(v0[0], v0[1]); w.y = pg8::cvt_pk_bf16(v0[2], v0[3]); w.z = pg8::cvt_pk_bf16(v1[0], v1[1]); w.w = pg8::cvt_pk_bf16(v1[2], v1[3]);
                    *(v4u*)(rowp + bj * 128) = w; } }
    }
};

__device__ __forceinline__ void unpack8(const v4u w, float (&f)[8]) { f[0] = bflo(w.x); f[1] = bfhi(w.x); f[2] = bflo(w.y); f[3] = bfhi(w.y); f[4] = bflo(w.z); f[5] = bfhi(w.z); f[6] = bflo(w.w); f[7] = bfhi(w.w); }
__device__ __forceinline__ void p3a_convmix(Frame& F) {
    const bf16* P = (const bf16*)(F.ws + WS_PBCU); bf16* Y = (bf16*)(F.ws + WS_R1);
    const int ch = 8 * F.lane;
    float w0[8], w1[8], w2[8], nw[8];
#pragma unroll
    for (int e = 0; e < 8; ++e) { w0[e] = F.conv_w[ch + e]; w1[e] = F.conv_w[DC + ch + e]; w2[e] = F.conv_w[2 * DC + ch + e]; nw[e] = F.conv_norm_w[ch + e]; }
    for (int gw = F.vcu * NWAVES + F.wave; gw < T / 16; gw += F.G * NWAVES) {
    const int m0 = gw * 16, t0 = m0 & (SEQ - 1);
    float p1[8], p2[8];
#pragma unroll
    for (int e = 0; e < 8; ++e) { p1[e] = 0.f; p2[e] = 0.f; }
    if (t0 != 0) {
        float c1[8], u1[8], c2[8], u2[8];
        unpack8(*(const GAS v4u*)(P + (size_t)(m0 - 1) * 1536 + 512 + ch), c1); unpack8(*(const GAS v4u*)(P + (size_t)(m0 - 1) * 1536 + 1024 + ch), u1);
        unpack8(*(const GAS v4u*)(P + (size_t)(m0 - 2) * 1536 + 512 + ch), c2); unpack8(*(const GAS v4u*)(P + (size_t)(m0 - 2) * 1536 + 1024 + ch), u2);
#pragma unroll
        for (int e = 0; e < 8; ++e) { p1[e] = c1[e] * u1[e]; p2[e] = c2[e] * u2[e]; }
    }
#pragma unroll 4
    for (int r = 0; r < 16; ++r) {
        const int m = m0 + r;
        float bb[8], cc[8], uu[8];
        unpack8(*(const GAS v4u*)(P + (size_t)m * 1536 + ch), bb); unpack8(*(const GAS v4u*)(P + (size_t)m * 1536 + 512 + ch), cc); unpack8(*(const GAS v4u*)(P + (size_t)m * 1536 + 1024 + ch), uu);
        float y[8]; float ss = 0.f;
#pragma unroll
        for (int e = 0; e < 8; ++e) { const float cu = cc[e] * uu[e]; y[e] = bb[e] * (w0[e] * p2[e] + w1[e] * p1[e] + w2[e] * cu); p2[e] = p1[e]; p1[e] = cu; ss += y[e] * y[e]; }
        ss += __shfl_xor(ss, 1); ss += __shfl_xor(ss, 2); ss += __shfl_xor(ss, 4);
        const float rr = 1.0f / sqrtf(ss * (1.0f / 64.0f) + RMS_EPS);
        v4u o; o.x = pk2(y[0] * rr * nw[0], y[1] * rr * nw[1]); o.y = pk2(y[2] * rr * nw[2], y[3] * rr * nw[3]); o.z = pk2(y[4] * rr * nw[4], y[5] * rr * nw[5]); o.w = pk2(y[6] * rr * nw[6], y[7] * rr * nw[7]);
        *(GAS v4u*)(Y + (size_t)m * D + ch) = o;
    }
    }
}
#if LEVEL < 3
__device__ __forceinline__ void zero_ydelta(Frame& F) {
    bf16* Y = (bf16*)(F.ws + WS_R1);
    for (int gw = F.vcu * NWAVES + F.wave; gw < T / 16; gw += F.G * NWAVES)
    for (int r = 0; r < 16; ++r) { const int m = gw * 16 + r; *(GAS v4u*)(Y + (size_t)m * D + 512 + 8 * F.lane) = (v4u){0u, 0u, 0u, 0u}; }
}
#endif

template <int I>
__device__ __forceinline__ void solve_row(float (&x)[64], const LAS float* As, const LAS float* src, const LAS float* sbeta, const LAS float* seg, const float wsel) {
    const float eg = seg[I];
    float rhs = sbeta[I] * src[I * 132] * (wsel * eg + (1.0f - wsel));
    float r4[4] = {0.f, 0.f, 0.f, 0.f};
#pragma unroll
    for (int jb = 0; jb < (I + 3) / 4; ++jb) {
        const f32x4 a = *(const LAS f32x4*)(As + I * 68 + 4 * jb);
#pragma unroll
        for (int e = 0; e < 4; ++e) if (4 * jb + e < I) r4[e] += a[e] * x[4 * jb + e];
    }
    x[I] = rhs - ((r4[0] + r4[1]) + (r4[2] + r4[3]));
    asm volatile("" ::: "memory");
}
template <int... Is>
__device__ __forceinline__ void solve_rows(float (&x)[64], const LAS float* As, const LAS float* src, const LAS float* sbeta, const LAS float* seg, const float wsel, std::integer_sequence<int, Is...>) {
    (solve_row<Is>(x, As, src, sbeta, seg, wsel), ...);
}
__device__ __forceinline__ void dn_pre(Frame& F) {
    LAS float* qs = (LAS float*)(F.lds);
    LAS float* ks = qs + 64 * 132;
    LAS float* vs = ks + 64 * 132;
    LAS float* As = vs + 64 * 132;
    LAS float* sgc = As + 64 * 68;
    LAS float* sbeta = sgc + 64;
    LAS float* seg = sbeta + 64;
    LAS float* seke = seg + 64;
    const bf16* PQ = (const bf16*)(F.ws + WS_PQKV); const float* BA = (const float*)(F.ws + WS_BA);
    const int tid = F.tid;
    for (int cid = F.vcu; cid < NCHUNK_ALL; cid += F.G) {
        const int b = cid >> 7, h = (cid >> 5) & 3, n = cid & 31;
        const int mbase = b * SEQ + n * CHK;
        if (tid < 384) {
            const int g8 = tid % 48, seg8 = tid / 48, part = g8 >> 4, cc = (g8 & 15) * 8, col = part * 512 + h * HD + cc;
            float w[4][8];
#pragma unroll
            for (int k = 0; k < 4; ++k)
#pragma unroll
                for (int e = 0; e < 8; ++e) w[k][e] = F.dn_conv_w[k * 1536 + col + e];
            float r0[8], r1[8], r2[8], r3[8];
            const int ts = seg8 * 8;
#define DN_LOADROW(dst, t) do { if (n * CHK + (t) >= 0) unpack8(*(const GAS v4u*)(PQ + (size_t)(mbase + (t)) * 1536 + col), dst); else { _Pragma("unroll") for (int e = 0; e < 8; ++e) dst[e] = 0.f; } } while (0)
            DN_LOADROW(r0, ts - 3); DN_LOADROW(r1, ts - 2); DN_LOADROW(r2, ts - 1);
            LAS float* dst = (part == 0 ? qs : (part == 1 ? ks : vs)) + cc;
#pragma unroll
            for (int tt = 0; tt < 8; ++tt) {
                const int t = ts + tt;
                DN_LOADROW(r3, t);
                float o[8];
#pragma unroll
                for (int e = 0; e < 8; ++e) { o[e] = siluf(w[0][e] * r0[e] + w[1][e] * r1[e] + w[2][e] * r2[e] + w[3][e] * r3[e]); r0[e] = r1[e]; r1[e] = r2[e]; r2[e] = r3[e]; }
                *(LAS f32x4*)(dst + t * 132) = (f32x4){o[0], o[1], o[2], o[3]}; *(LAS f32x4*)(dst + t * 132 + 4) = (f32x4){o[4], o[5], o[6], o[7]};
            }
#undef DN_LOADROW
        } else if (tid < 448) {
            const int i = F.lane;
            const float bl = BA[(size_t)(mbase + i) * 8 + h], al = BA[(size_t)(mbase + i) * 8 + 4 + h];
            const float beta = 1.0f / (1.0f + __expf(-bl));
            const float xx = al + F.dn_dt_bias[h];
            const float sp = xx > 20.f ? xx : log1pf(__expf(xx));
            float v = -__expf(F.dn_A_log[h]) * sp;
#pragma unroll
            for (int o = 1; o < 64; o <<= 1) { const float tq = __shfl_up(v, o); if (i >= o) v += tq; }
            const float g63 = __shfl(v, 63);
            sgc[i] = v; sbeta[i] = beta; seg[i] = __expf(v); seke[i] = __expf(g63 - v);
            if (i == 63) ((float*)(F.ws + WS_DEC))[cid] = __expf(v);
        }
        __syncthreads();
        if (tid < 512) {
            const int row = tid >> 2, part = tid & 3;
            LAS float* p = (row < 64 ? qs + row * 132 : ks + (row - 64) * 132) + part * 32;
            f32x4 vv[8]; float ss = 0.f;
#pragma unroll
            for (int e = 0; e < 8; ++e) { vv[e] = *(LAS f32x4*)(p + 4 * e); ss += (vv[e].x * vv[e].x + vv[e].y * vv[e].y) + (vv[e].z * vv[e].z + vv[e].w * vv[e].w); }
            ss += __shfl_xor(ss, 1); ss += __shfl_xor(ss, 2);
            const float rs = (1.0f / sqrtf(ss + RMS_EPS)) * (row < 64 ? 0.08838834764831845f : 1.0f);
#pragma unroll
            for (int e = 0; e < 8; ++e) *(LAS f32x4*)(p + 4 * e) = vv[e] * rs;
        }
        __syncthreads();
        if (tid < 136) {
            int bi = 0; while (((bi + 1) * (bi + 2)) / 2 <= tid) ++bi;
            const int bj = tid - (bi * (bi + 1)) / 2, i0 = 4 * bi, j0 = 4 * bj;
            float acc[4][4];
#pragma unroll
            for (int r = 0; r < 4; ++r)
#pragma unroll
                for (int c = 0; c < 4; ++c) acc[r][c] = 0.f;
#pragma unroll 4
            for (int e = 0; e < 32; ++e) {
                f32x4 a[4], bb[4];
#pragma unroll
                for (int r = 0; r < 4; ++r) { a[r] = *(const LAS f32x4*)(ks + (i0 + r) * 132 + 4 * e); bb[r] = *(const LAS f32x4*)(ks + (j0 + r) * 132 + 4 * e); }
#pragma unroll
                for (int r = 0; r < 4; ++r)
#pragma unroll
                    for (int c = 0; c < 4; ++c) acc[r][c] += (a[r].x * bb[c].x + a[r].y * bb[c].y) + (a[r].z * bb[c].z + a[r].w * bb[c].w);
            }
#pragma unroll
            for (int r = 0; r < 4; ++r) { const int i = i0 + r; const float bi_ = sbeta[i], gi = sgc[i];
#pragma unroll
                for (int c = 0; c < 4; ++c) { const int j = j0 + c; As[i * 68 + j] = (i > j) ? bi_ * acc[r][c] * __expf(gi - sgc[j]) : 0.f; } }
        } else if (tid >= 256) {
            const int t2 = tid - 256, bi = t2 >> 4, bj = t2 & 15, i0 = 4 * bi, j0 = 4 * bj;
            float acc[4][4];
#pragma unroll
            for (int r = 0; r < 4; ++r)
#pragma unroll
                for (int c = 0; c < 4; ++c) acc[r][c] = 0.f;
            if (bi >= bj) {
#pragma unroll 4
                for (int e = 0; e < 32; ++e) {
                    f32x4 a[4], bb[4];
#pragma unroll
                    for (int r = 0; r < 4; ++r) { a[r] = *(const LAS f32x4*)(qs + (i0 + r) * 132 + 4 * e); bb[r] = *(const LAS f32x4*)(ks + (j0 + r) * 132 + 4 * e); }
#pragma unroll
                    for (int r = 0; r < 4; ++r)
#pragma unroll
                        for (int c = 0; c < 4; ++c) acc[r][c] += (a[r].x * bb[c].x + a[r].y * bb[c].y) + (a[r].z * bb[c].z + a[r].w * bb[c].w);
                }
            }
            bf16* G = (bf16*)(F.ws + WS_DNG) + (size_t)cid * 4096;
#pragma unroll
            for (int r = 0; r < 4; ++r) { const int i = i0 + r; const float gi = sgc[i]; float o[4];
#pragma unroll
                for (int c = 0; c < 4; ++c) { const int j = j0 + c; o[c] = (i >= j) ? acc[r][c] * __expf(gi - sgc[j]) : 0.f; }
                *(GAS v2u*)(G + i * 64 + j0) = (v2u){pk2(o[0], o[1]), pk2(o[2], o[3])}; }
        }
        __syncthreads();
        if (tid < 256) {
            const int c = tid;
            const LAS float* src = (c < 128) ? (vs + c) : (ks + (c - 128));
            float x[64];
            int zv; asm volatile("v_mov_b32 %0, 0" : "=v"(zv));
            solve_rows(x, As + zv, src, sbeta + zv, seg + zv, c >= 128 ? 1.0f : 0.0f, std::make_integer_sequence<int, 64>{});
            if (c < 128) {
                bf16* U = (bf16*)(F.ws + WS_DNU) + ((size_t)cid * 128 + c) * 64;
#pragma unroll
                for (int g = 0; g < 8; ++g) *(GAS v4u*)(U + 8 * g) = (v4u){pk2(x[8 * g], x[8 * g + 1]), pk2(x[8 * g + 2], x[8 * g + 3]), pk2(x[8 * g + 4], x[8 * g + 5]), pk2(x[8 * g + 6], x[8 * g + 7])};
            } else {
                bf16* W = (bf16*)(F.ws + WS_DNW) + (size_t)cid * 8192 + (c - 128);
#pragma unroll
                for (int i = 0; i < 64; ++i) W[i * 128] = (bf16)f2bf(x[i]);
            }
        } else {
            const int t2 = tid - 256;
            bf16* Q = (bf16*)(F.ws + WS_DNQ) + (size_t)cid * 8192; bf16* KT = (bf16*)(F.ws + WS_DNK) + (size_t)cid * 8192;
#pragma unroll
            for (int r = 0; r < 4; ++r) { const int task = t2 + 256 * r, i = task >> 4, d0 = (task & 15) * 8; const float sc = seg[i];
                const f32x4 a = *(const LAS f32x4*)(qs + i * 132 + d0), bq = *(const LAS f32x4*)(qs + i * 132 + d0 + 4);
                *(GAS v4u*)(Q + i * 128 + d0) = (v4u){pk2(a.x * sc, a.y * sc), pk2(a.z * sc, a.w * sc), pk2(bq.x * sc, bq.y * sc), pk2(bq.z * sc, bq.w * sc)}; }
#pragma unroll
            for (int r = 0; r < 4; ++r) { const int task = t2 + 256 * r, d = task & 127, t0 = (task >> 7) * 8; float o[8];
#pragma unroll
                for (int e = 0; e < 8; ++e) o[e] = ks[(t0 + e) * 132 + d] * seke[t0 + e];
                *(GAS v4u*)(KT + d * 64 + t0) = (v4u){pk2(o[0], o[1]), pk2(o[2], o[3]), pk2(o[4], o[5]), pk2(o[6], o[7])}; }
        }
        __syncthreads();
    }
}

__device__ __forceinline__ bf16x8 pack8(const f32x4 a, const f32x4 b) {
    const v4u w = (v4u){pg8::cvt_pk_bf16(a.x, a.y), pg8::cvt_pk_bf16(a.z, a.w), pg8::cvt_pk_bf16(b.x, b.y), pg8::cvt_pk_bf16(b.z, b.w)};
    return __builtin_bit_cast(bf16x8, w);
}
__device__ __forceinline__ bf16x8 ldfrag(const LAS unsigned char* base, int stride, int row, int s, int q) {
    const LAS unsigned char* p = base + row * stride + 64 * s + 8 * q;
    const v2u lo = *(const LAS v2u*)p, hi = *(const LAS v2u*)(p + 32);
    return __builtin_bit_cast(bf16x8, (v4u){lo.x, lo.y, hi.x, hi.y});
}
__device__ __forceinline__ void dn_scan(Frame& F) {
    if (blockIdx.x >= NB * NH) return;
    const int item = blockIdx.x, b = item >> 2, h = item & 3;
    const int tid = F.tid, lane = F.lane, wave = F.wave, col = lane & 15, q = lane >> 4, c0 = wave * 16;
    LAS unsigned char* L = F.lds;
    constexpr int WL = 0, QL = 17408, KL = 34816, GL = 53248, RED = 62464;
    LAS float* red = (LAS float*)(L + RED);
    f32x4 S[8];
#pragma unroll
    for (int i = 0; i < 8; ++i) S[i] = (f32x4){0.f, 0.f, 0.f, 0.f};
    const float nw = F.dn_norm_w[c0 + col];
    const bf16* PZ = (const bf16*)(F.ws + WS_PZ); bf16* Y = (bf16*)(F.ws + WS_R1);
    int zero; asm volatile("v_mov_b32 %0, 0" : "=v"(zero));
    v4u pf[7]; v2u pu[4]; bf16 pz[16]; float pdec;
#define SCAN_LOAD(n_) do { const int cid_ = item * 32 + (n_); \
        const GAS v4u* gw_ = (const GAS v4u*)(F.ws + WS_DNW + (size_t)cid_ * 16384); const GAS v4u* gq_ = (const GAS v4u*)(F.ws + WS_DNQ + (size_t)cid_ * 16384); \
        const GAS v4u* gk_ = (const GAS v4u*)(F.ws + WS_DNK + (size_t)cid_ * 16384); const GAS v4u* gg_ = (const GAS v4u*)(F.ws + WS_DNG + (size_t)cid_ * 8192); \
        pf[0] = gw_[tid]; pf[1] = gw_[tid + 512]; pf[2] = gq_[tid]; pf[3] = gq_[tid + 512]; pf[4] = gk_[tid]; pf[5] = gk_[tid + 512]; pf[6] = gg_[tid]; \
        const bf16* up_ = (const bf16*)(F.ws + WS_DNU) + ((size_t)cid_ * 128 + c0 + col) * 64 + 4 * q; \
        _Pragma("unroll") for (int mt = 0; mt < 4; ++mt) pu[mt] = *(const GAS v2u*)(up_ + 16 * mt); \
        const bf16* zp_ = PZ + (size_t)(b * SEQ + (n_) * CHK + 4 * q) * 512 + h * HD + c0 + col; \
        _Pragma("unroll") for (int mt = 0; mt < 4; ++mt) _Pragma("unroll") for (int r = 0; r < 4; ++r) pz[mt * 4 + r] = zp_[(size_t)(16 * mt + r) * 512]; \
        pdec = ((const float*)(F.ws + WS_DEC))[cid_ + zero]; } while (0)
    SCAN_LOAD(0);
    for (int n = 0; n < NCHUNK; ++n) {
        __syncthreads();
        { int p = tid; *(LAS v4u*)(L + WL + (p >> 4) * 272 + (p & 15) * 16) = pf[0]; *(LAS v4u*)(L + QL + (p >> 4) * 272 + (p & 15) * 16) = pf[2];
          *(LAS v4u*)(L + KL + (p >> 3) * 144 + (p & 7) * 16) = pf[4]; *(LAS v4u*)(L + GL + (p >> 3) * 144 + (p & 7) * 16) = pf[6];
          p = tid + 512; *(LAS v4u*)(L + WL + (p >> 4) * 272 + (p & 15) * 16) = pf[1]; *(LAS v4u*)(L + QL + (p >> 4) * 272 + (p & 15) * 16) = pf[3];
          *(LAS v4u*)(L + KL + (p >> 3) * 144 + (p & 7) * 16) = pf[5]; }
        f32x4 u[4]; float z[16]; const float dec = pdec;
#pragma unroll
        for (int mt = 0; mt < 4; ++mt) u[mt] = (f32x4){bflo(pu[mt].x), bfhi(pu[mt].x), bflo(pu[mt].y), bfhi(pu[mt].y)};
#pragma unroll
        for (int i = 0; i < 16; ++i) z[i] = bf1(pz[i]);
        __syncthreads();
        if (n + 1 < NCHUNK) SCAN_LOAD(n + 1);
        bf16x8 Sb[4];
#pragma unroll
        for (int s = 0; s < 4; ++s) Sb[s] = pack8(S[2 * s], S[2 * s + 1]);
        f32x4 dl[4];
#pragma unroll
        for (int mt = 0; mt < 4; ++mt) { f32x4 acc = (f32x4){0.f, 0.f, 0.f, 0.f};
#pragma unroll
            for (int s = 0; s < 4; ++s) acc = __builtin_amdgcn_mfma_f32_16x16x32_bf16(ldfrag(L + WL, 272, 16 * mt + col, s, q), Sb[s], acc, 0, 0, 0);
            dl[mt] = u[mt] - acc; }
        bf16x8 Db[2];
#pragma unroll
        for (int s2 = 0; s2 < 2; ++s2) Db[s2] = pack8(dl[2 * s2], dl[2 * s2 + 1]);
        f32x4 o[4];
#pragma unroll
        for (int mt = 0; mt < 4; ++mt) { f32x4 acc = (f32x4){0.f, 0.f, 0.f, 0.f};
#pragma unroll
            for (int s = 0; s < 4; ++s) acc = __builtin_amdgcn_mfma_f32_16x16x32_bf16(ldfrag(L + QL, 272, 16 * mt + col, s, q), Sb[s], acc, 0, 0, 0);
#pragma unroll
            for (int s2 = 0; s2 < 2; ++s2) if (s2 == 0 || mt >= 2) acc = __builtin_amdgcn_mfma_f32_16x16x32_bf16(ldfrag(L + GL, 144, 16 * mt + col, s2, q), Db[s2], acc, 0, 0, 0);
            o[mt] = acc; }
#pragma unroll
        for (int m8 = 0; m8 < 8; ++m8) { f32x4 acc = S[m8] * dec;
#pragma unroll
            for (int s2 = 0; s2 < 2; ++s2) acc = __builtin_amdgcn_mfma_f32_16x16x32_bf16(ldfrag(L + KL, 144, 16 * m8 + col, s2, q), Db[s2], acc, 0, 0, 0);
            S[m8] = acc; }
#pragma unroll
        for (int mt = 0; mt < 4; ++mt)
#pragma unroll
            for (int r = 0; r < 4; ++r) { float p = o[mt][r] * o[mt][r]; p += __shfl_xor(p, 1); p += __shfl_xor(p, 2); p += __shfl_xor(p, 4); p += __shfl_xor(p, 8);
                if (col == 0) red[(16 * mt + 4 * q + r) * 8 + wave] = p; }
        __syncthreads();
#pragma unroll
        for (int mt = 0; mt < 4; ++mt)
#pragma unroll
            for (int r = 0; r < 4; ++r) { const int tok = 16 * mt + 4 * q + r;
                const f32x4 a = *(const LAS f32x4*)(red + tok * 8), c = *(const LAS f32x4*)(red + tok * 8 + 4);
                const float tot = ((a.x + a.y) + (a.z + a.w)) + ((c.x + c.y) + (c.z + c.w));
                const float rstd = 1.0f / sqrtf(tot * (1.0f / HD) + RMS_EPS);
                Y[(size_t)(b * SEQ + n * CHK + tok) * D + DD + h * HD + c0 + col] = (bf16)f2bf(o[mt][r] * rstd * nw * siluf(z[mt * 4 + r])); }
    }
#undef SCAN_LOAD
}

__device__ __forceinline__ void p5_ln1_router(Frame& F) {
#if LEVEL >= 4
    LAS float* wg = (LAS float*)(F.lds);
    LAS float* we = (LAS float*)(F.lds + 16384);
    for (int idx = F.tid; idx < 4096; idx += NTHR) { const int k = idx >> 2, q = idx & 3, j = k >> 8, l = (k >> 2) & 63, e = k & 3; wg[((j * 4 + e) * 64 + l) * 4 + q] = F.w_grp[idx]; }
    for (int idx = F.tid; idx < 32768; idx += NTHR) { const int k = idx >> 5, col = idx & 31, g = col >> 3, hf = (col >> 2) & 1, q = col & 3, j = k >> 8, l = (k >> 2) & 63, e = k & 3;
        we[((((g * 2 + hf) * 16) + (j * 4 + e)) * 64 + l) * 4 + q] = F.w_exp[idx]; }
    __syncthreads();
#endif
    const float* MOD = (const float*)(F.ws + WS_MOD);
    const bf16* MIX = (const bf16*)(F.ws + WS_MIX); float* X1 = (float*)(F.ws + WS_X1); bf16* H2 = (bf16*)(F.ws + WS_R1);
    for (int gw = F.vcu * NWAVES + F.wave; gw < T / 16; gw += F.G * NWAVES) {
    const int m0 = gw * 16, b = m0 >> 11;
    f32x4 g1[4], sc2[4], sh2[4], lg[4], lb[4];
#pragma unroll
    for (int j = 0; j < 4; ++j) { const int co = 256 * j + 4 * F.lane;
        g1[j] = *(const f32x4*)(MOD + b * 6144 + 2 * D + co); sh2[j] = *(const f32x4*)(MOD + b * 6144 + 3 * D + co); sc2[j] = *(const f32x4*)(MOD + b * 6144 + 4 * D + co);
        lg[j] = *(const f32x4*)(F.ln1_g + co); lb[j] = *(const f32x4*)(F.ln1_b + co); }
    for (int r = 0; r < 16; ++r) {
        const int m = m0 + r;
        const GAS f32x4* xr = (const GAS f32x4*)(F.x + (size_t)m * D) + F.lane;
        const GAS v2u* mr = (const GAS v2u*)(MIX + (size_t)m * D) + F.lane;
        f32x4 v[4]; float s = 0.f;
#pragma unroll
        for (int j = 0; j < 4; ++j) { const f32x4 xv = xr[64 * j];
#if LEVEL >= 2
            const v2u mw = mr[64 * j]; const f32x4 mv = (f32x4){bflo(mw.x), bfhi(mw.x), bflo(mw.y), bfhi(mw.y)};
            v[j] = xv * ALPHA + g1[j] * mv;
#else
            (void)mr; v[j] = xv * ALPHA;
#endif
            s += (v[j].x + v[j].y) + (v[j].z + v[j].w); }
        const float mean = wave_sum(s) * (1.f / D); float s2 = 0.f;
#pragma unroll
        for (int j = 0; j < 4; ++j) { v[j] = v[j] - mean; s2 += (v[j].x * v[j].x + v[j].y * v[j].y) + (v[j].z * v[j].z + v[j].w * v[j].w); }
        const float rstd = 1.f / sqrtf(wave_sum(s2) * (1.f / D) + LN_EPS);
        GAS f32x4* x1r = (GAS f32x4*)(X1 + (size_t)m * D) + F.lane;
        GAS unsigned long long* o8 = (GAS unsigned long long*)(H2 + (size_t)m * D) + F.lane;
        f32x4 h[4];
#pragma unroll
        for (int j = 0; j < 4; ++j) { const f32x4 x1 = v[j] * rstd * lg[j] + lb[j]; x1r[64 * j] = x1; h[j] = x1 * (sc2[j] + 1.0f) + sh2[j];
            o8[64 * j] = (unsigned long long)pk2(h[j].x, h[j].y) | ((unsigned long long)pk2(h[j].z, h[j].w) << 32); }
#if LEVEL >= 4
        float a[4] = {0.f, 0.f, 0.f, 0.f};
#pragma unroll
        for (int j = 0; j < 4; ++j)
#pragma unroll
            for (int e = 0; e < 4; ++e) { const float hv = h[j][e]; const f32x4 w = *(const LAS f32x4*)(wg + ((j * 4 + e) * 64 + F.lane) * 4); a[0] += hv * w.x; a[1] += hv * w.y; a[2] += hv * w.z; a[3] += hv * w.w; }
        int g = 0; float gmax = -3.0e38f, gl[4];
#pragma unroll
        for (int q = 0; q < 4; ++q) { gl[q] = wave_sum(a[q]) + F.b_grp[q]; if (gl[q] > gmax) { gmax = gl[q]; g = q; } }
        g = __builtin_amdgcn_readfirstlane(g);
        float gs = 0.f;
#pragma unroll
        for (int q = 0; q < 4; ++q) gs += __expf(gl[q] - gmax);
        const float grp_w = 1.0f / gs;
        float ea[8];
#pragma unroll
        for (int q = 0; q < 8; ++q) ea[q] = 0.f;
        const LAS float* weg = we + (size_t)g * (2 * 16 * 64 * 4);
#pragma unroll
        for (int j = 0; j < 4; ++j)
#pragma unroll
            for (int e = 0; e < 4; ++e) { const float hv = h[j][e];
                const f32x4 w0 = *(const LAS f32x4*)(weg + ((0 * 16 + (j * 4 + e)) * 64 + F.lane) * 4), w1 = *(const LAS f32x4*)(weg + ((1 * 16 + (j * 4 + e)) * 64 + F.lane) * 4);
                ea[0] += hv * w0.x; ea[1] += hv * w0.y; ea[2] += hv * w0.z; ea[3] += hv * w0.w; ea[4] += hv * w1.x; ea[5] += hv * w1.y; ea[6] += hv * w1.z; ea[7] += hv * w1.w; }
        float el[8]; int i1 = 0; float m1 = -3.0e38f;
#pragma unroll
        for (int q = 0; q < 8; ++q) { el[q] = wave_sum(ea[q]) + F.b_exp[g * 8 + q]; if (el[q] > m1) { m1 = el[q]; i1 = q; } }
        int i2 = 0; float m2 = -3.0e38f;
#pragma unroll
        for (int q = 0; q < 8; ++q) if (q != i1 && el[q] > m2) { m2 = el[q]; i2 = q; }
        const float e2 = __expf(m2 - m1), inv = 1.0f / (1.0f + e2);
        if (F.lane < 2) {
            const int e = g * 8 + (F.lane == 0 ? i1 : i2); const float gate = grp_w * (F.lane == 0 ? inv : e2 * inv);
            unsigned* cnt = (unsigned*)(F.ws + WS_CTL) + CW_CNT;
            const unsigned rk = __hip_atomic_fetch_add(cnt + e, 1u, RLX_AGENT);
            ((int*)(F.ws + WS_ELIST))[(size_t)e * 65536 + rk] = m;
            ((int*)(F.ws + WS_TOKE))[m * 2 + F.lane] = e; ((int*)(F.ws + WS_TOKR))[m * 2 + F.lane] = (int)rk; ((float*)(F.ws + WS_TOKG))[m * 2 + F.lane] = gate;
        }
#endif
    }
    }
}

constexpr int TS_OFF = LDSCTL_OFF, EC_OFF = LDSCTL_OFF + 256;
__device__ __forceinline__ void moe_tables(Frame& F) {
    LAS int* tstart = (LAS int*)(F.lds + TS_OFF); LAS int* ecnt = (LAS int*)(F.lds + EC_OFF);
    if (F.tid == 0) { unsigned* cnt = (unsigned*)(F.ws + WS_CTL) + CW_CNT; int acc = 0;
        for (int e = 0; e < NE; ++e) { const int c = (int)__hip_atomic_load(cnt + e, RLX_AGENT); ecnt[e] = c; tstart[e] = acc; acc += (c + 255) >> 8; }
        tstart[NE] = acc; }
    __syncthreads();
}
__device__ __forceinline__ int moe_find(const LAS int* tstart, int rt) { int e = 0;
#pragma unroll 1
    for (int k = 1; k < NE; ++k) if (tstart[k] <= rt) e = k;
    return e; }
struct MoeGU {
    static constexpr bool GATHER = true;
    const char* H2; const char* WGU; const LAS int* tstart; const LAS int* xtok; int nunits, G, c;
    __device__ __forceinline__ bool next(int i, pg8::Unit& u) const {
        const int L = i * G + c; if (L >= nunits) return false;
        const int rt = L >> 1, pn = L & 1, e = moe_find(tstart, rt);
        u.a = H2; u.b = WGU + ((size_t)e * 512 + (size_t)pn * 256) * D * 2; u.i0 = rt; u.i1 = pn; u.i2 = e; return true;
    }
    __device__ __forceinline__ void a_off(const pg8::Unit&, int ui, unsigned (&vo)[2][2], const int (&R)[2], const int (&C)[2], int K_) const {
#pragma unroll
        for (int h = 0; h < 2; ++h)
#pragma unroll
            for (int i = 0; i < 2; ++i) vo[h][i] = (unsigned)(xtok[ui * 256 + h * 128 + R[i]] * K_ + C[i]) * 2u;
    }
};
struct MoeDown {
    static constexpr bool GATHER = false;
    const char* HID; const char* WD; const LAS int* tstart; int nunits, G, c;
    __device__ __forceinline__ bool next(int i, pg8::Unit& u) const {
        const int L = i * G + c; if (L >= nunits) return false;
        const int rt = L >> 2, pn = L & 3, e = moe_find(tstart, rt);
        u.a = HID + (size_t)rt * 256 * DE * 2; u.b = WD + ((size_t)e * D + (size_t)pn * 256) * DE * 2; u.i0 = rt; u.i1 = pn; u.i2 = e; return true;
    }
    __device__ __forceinline__ void a_off(const pg8::Unit&, int, unsigned (&vo)[2][2], const int (&R)[2], const int (&C)[2], int K_) const {
#pragma unroll
        for (int h = 0; h < 2; ++h)
#pragma unroll
            for (int i = 0; i < 2; ++i) vo[h][i] = (unsigned)((h * 128 + R[i]) * K_ + C[i]) * 2u;
    }
};
struct EpiGU {
    static constexpr bool PERM = true;
    bf16* HID;
    __device__ __forceinline__ void operator()(const f32x4 (&acc)[2][2][4][2], const pg8::Unit& u, int wr, int wc, int fr, int fq) const {
        const int row0 = u.i0 * 256 + wr * 64 + fr, col0 = u.i1 * 128 + wc * 32 + 8 * fq;
#pragma unroll
        for (int ai = 0; ai < 2; ++ai)
#pragma unroll
            for (int m = 0; m < 4; ++m) { bf16* rowp = HID + (size_t)(row0 + ai * 128 + m * 16) * DE + col0;
                const f32x4 g0 = acc[ai][0][m][0], g1 = acc[ai][0][m][1], u0 = acc[ai][1][m][0], u1 = acc[ai][1][m][1];
                v4u w; w.x = pg8::cvt_pk_bf16(siluf(g0[0]) * u0[0], siluf(g0[1]) * u0[1]); w.y = pg8::cvt_pk_bf16(siluf(g0[2]) * u0[2], siluf(g0[3]) * u0[3]);
                w.z = pg8::cvt_pk_bf16(siluf(g1[0]) * u1[0], siluf(g1[1]) * u1[1]); w.w = pg8::cvt_pk_bf16(siluf(g1[2]) * u1[2], siluf(g1[3]) * u1[3]);
                *(v4u*)rowp = w; }
    }
};
__device__ __forceinline__ void p7_gateup(Frame& F) {
    moe_tables(F);
    const LAS int* tstart = (const LAS int*)(F.lds + TS_OFF); const LAS int* ecnt = (const LAS int*)(F.lds + EC_OFF);
    LAS int* xtok = (LAS int*)(F.lds + XTOK_OFF);
    MoeGU S{(const char*)(F.ws + WS_R1), (const char*)(F.ws + WS_WGU), tstart, xtok, 2 * tstart[NE], F.G, F.vcu};
    pg8::Unit u;
    for (int ui = 0; ui < 8 && S.next(ui, u); ++ui) {
        if (F.tid < 256) { const int e = u.i2, idx = (u.i0 - tstart[e]) * 256 + F.tid;
            xtok[ui * 256 + F.tid] = idx < ecnt[e] ? ((const int*)(F.ws + WS_ELIST))[(size_t)e * 65536 + idx] : 0; }
    }
    __syncthreads();
    EpiGU E{(bf16*)(F.ws + WS_HID)};
    pg8::gemm_phase<EpiGU, MoeGU, true, true>(F.lds + RING_OFF, D, S, E);
}
__device__ __forceinline__ void p8_down(Frame& F) {
    moe_tables(F);
    const LAS int* tstart = (const LAS int*)(F.lds + TS_OFF);
    MoeDown S{(const char*)(F.ws + WS_HID), (const char*)(F.ws + WS_WD), tstart, 4 * tstart[NE], F.G, F.vcu};
    EpiBf E{(bf16*)(F.ws + WS_YR), D};
    int Kd = DE; asm volatile("" : "+s"(Kd));
    pg8::gemm_phase<EpiBf, MoeDown, true, true>(F.lds + RING_OFF, Kd, S, E);
}

__device__ __forceinline__ void p9_final(Frame& F) {
    const float* MOD = (const float*)(F.ws + WS_MOD);
    const float* X1 = (const float*)(F.ws + WS_X1);
#if LEVEL >= 4
    LAS int* pst = (LAS int*)(F.lds);
    if (F.tid == 0) { unsigned* cnt = (unsigned*)(F.ws + WS_CTL) + CW_CNT; int acc = 0; for (int e = 0; e < NE; ++e) { pst[e] = acc; acc += (int)((__hip_atomic_load(cnt + e, RLX_AGENT) + 255u) & ~255u); } }
    __syncthreads();
    const bf16* YR = (const bf16*)(F.ws + WS_YR);
#endif
    for (int gw = F.vcu * NWAVES + F.wave; gw < T / 16; gw += F.G * NWAVES) {
    const int m0 = gw * 16, b = m0 >> 11;
    f32x4 g2[4], lg[4], lb[4];
#pragma unroll
    for (int j = 0; j < 4; ++j) { const int co = 256 * j + 4 * F.lane; g2[j] = *(const f32x4*)(MOD + b * 6144 + 5 * D + co); lg[j] = *(const f32x4*)(F.ln2_g + co); lb[j] = *(const f32x4*)(F.ln2_b + co); }
    for (int r = 0; r < 16; ++r) {
        const int m = m0 + r;
        const GAS f32x4* xr = (const GAS f32x4*)(X1 + (size_t)m * D) + F.lane;
        f32x4 v[4]; float s = 0.f;
#if LEVEL >= 4
        const int l1 = F.lane & 1;
        const int ee = ((const int*)(F.ws + WS_TOKE))[m * 2 + l1], rr = ((const int*)(F.ws + WS_TOKR))[m * 2 + l1]; const float gg = ((const float*)(F.ws + WS_TOKG))[m * 2 + l1];
        const int sl = pst[ee] + rr;
        const int s0 = __shfl(sl, 0), s1 = __shfl(sl, 1); const float ga = __shfl(gg, 0), gb = __shfl(gg, 1);
        const GAS v2u* y0 = (const GAS v2u*)(YR + (size_t)s0 * D) + F.lane; const GAS v2u* y1 = (const GAS v2u*)(YR + (size_t)s1 * D) + F.lane;
#endif
#pragma unroll
        for (int j = 0; j < 4; ++j) { const f32x4 xv = xr[64 * j];
#if LEVEL >= 4
            const v2u a = y0[64 * j], c = y1[64 * j];
            const f32x4 f = (f32x4){bflo(a.x), bfhi(a.x), bflo(a.y), bfhi(a.y)} * ga + (f32x4){bflo(c.x), bfhi(c.x), bflo(c.y), bfhi(c.y)} * gb;
            v[j] = xv * ALPHA + g2[j] * f;
#else
            v[j] = xv * ALPHA;
#endif
            s += (v[j].x + v[j].y) + (v[j].z + v[j].w); }
        const float mean = wave_sum(s) * (1.f / D); float s2 = 0.f;
#pragma unroll
        for (int j = 0; j < 4; ++j) { v[j] = v[j] - mean; s2 += (v[j].x * v[j].x + v[j].y * v[j].y) + (v[j].z * v[j].z + v[j].w * v[j].w); }
        const float rstd = 1.f / sqrtf(wave_sum(s2) * (1.f / D) + LN_EPS);
        GAS f32x4* orow = (GAS f32x4*)(F.out + (size_t)m * D) + F.lane;
#pragma unroll
        for (int j = 0; j < 4; ++j) orow[64 * j] = v[j] * rstd * lg[j] + lb[j];
    }
    (void)g2;
    }
}

constexpr int NPHASE = 10;
struct Args { const float* in[23]; float* out; unsigned char* ws; int ph_lo, ph_hi; };
__global__ void __launch_bounds__(NTHR, 2) fwd_kernel(Args args) {
    extern __shared__ __attribute__((aligned(16))) unsigned char lds[];
    Frame F;
    F.lds = (LAS unsigned char*)lds;
    F.tid = threadIdx.x; F.lane = F.tid & 63; F.wave = __builtin_amdgcn_readfirstlane(F.tid >> 6);
    F.G = gridDim.x; { const int bx = blockIdx.x; F.vcu = (F.G % 8 == 0) ? (bx % 8) * (F.G / 8) + bx / 8 : bx; }
    F.x = args.in[0]; F.c = args.in[1]; F.w_ada = args.in[2]; F.b_ada = args.in[3]; F.w_in = args.in[4]; F.conv_w = args.in[5]; F.conv_norm_w = args.in[6];
    F.dn_conv_w = args.in[7]; F.dn_A_log = args.in[8]; F.dn_dt_bias = args.in[9]; F.dn_norm_w = args.in[10]; F.w_out = args.in[11]; F.ln1_g = args.in[12]; F.ln1_b = args.in[13];
    F.w_grp = args.in[14]; F.b_grp = args.in[15]; F.w_exp = args.in[16]; F.b_exp = args.in[17]; F.w_gate = args.in[18]; F.w_up = args.in[19]; F.w_down = args.in[20];
    F.ln2_g = args.in[21]; F.ln2_b = args.in[22]; F.out = args.out; F.ws = args.ws;
    volatile LAS unsigned* MISC = (volatile LAS unsigned*)(F.lds + MISC_OFF);
    for (int u = F.tid; u < (LDS_BYTES - LDSCTL_OFF) / 4; u += NTHR) ((LAS unsigned*)(F.lds + LDSCTL_OFF))[u] = 0u;
    __syncthreads();
    XcdBarrier bar; bar.bar = (unsigned*)(F.ws + WS_CTL) + CW_BAR; bar.x = 0; bar.st = nullptr;
    const int lo = args.ph_lo, hi = args.ph_hi;
    if (hi - lo > 1) bar = xcd_barrier_post((unsigned*)(F.ws + WS_CTL) + CW_BAR, MISC + 8);
#define IN(k) (lo <= (k) && (k) < hi)
#define SEAM(k) do { if (IN(k) && IN((k) + 1)) xcd_barrier(bar); } while (0)

    if (IN(0)) { p0_prologue(F); } SEAM(0);
    if (IN(1)) { p1_modulate(F); } SEAM(1);
    if (IN(2)) {
#if LEVEL >= 2
        pg8::DenseOrder S; S.init(F.ws + WS_R1, F.ws + WS_WIN, T, NMAIN, D, F.G, (int)blockIdx.x);
        EpiP E{F.ws};
        pg8::gemm_phase<EpiP, pg8::DenseOrder, true, true>(F.lds + RING_OFF, D, S, E);
#endif
    } SEAM(2);
    if (IN(3)) {
#if LEVEL >= 2
        p3a_convmix(F);
#endif
#if LEVEL == 2
        zero_ydelta(F);
#endif
#if LEVEL >= 3 && !defined(NO_PRE)
        dn_pre(F);
#endif
    } SEAM(3);
    if (IN(4)) {
#if LEVEL >= 3 && !defined(NO_SCAN)
        dn_scan(F);
#endif
    } SEAM(4);
    if (IN(5)) {
#if LEVEL >= 2
        pg8::DenseOrder S; S.init(F.ws + WS_R1, F.ws + WS_WOUT, T, D, D, F.G, (int)blockIdx.x);
        EpiBf E{(bf16*)(F.ws + WS_MIX), D};
        pg8::gemm_phase<EpiBf, pg8::DenseOrder, true, true>(F.lds + RING_OFF, D, S, E);
#endif
    } SEAM(5);
    if (IN(6)) { p5_ln1_router(F); } SEAM(6);
    if (IN(7)) {
#if LEVEL >= 4
        p7_gateup(F);
#endif
    } SEAM(7);
    if (IN(8)) {
#if LEVEL >= 4
        p8_down(F);
#endif
    } SEAM(8);
    if (IN(9)) { p9_final(F); }
#undef IN
#undef SEAM
}

extern "C" void kernel_launch(void* const* d_in, const int* in_sizes, int n_in, void* d_out, int out_size, void* d_ws, size_t ws_size, hipStream_t stream) {
    static int grid = 0;
    if (grid == 0) {
        if (n_in != 23 || in_sizes[0] != T * D || out_size != T * D || ws_size < WS_END) { fprintf(stderr, "kernel_launch: unexpected shapes (n_in %d, in0 %d, out %d, ws %zu)\n", n_in, n_in > 0 ? in_sizes[0] : -1, out_size, ws_size); grid = -1; return; }
        int dev = 0, cus = 0, per_cu = 0;
        if (hipGetDevice(&dev) != hipSuccess || hipDeviceGetAttribute(&cus, hipDeviceAttributeMultiprocessorCount, dev) != hipSuccess) { grid = -1; return; }
        if (hipFuncSetAttribute((const void*)fwd_kernel, hipFuncAttributeMaxDynamicSharedMemorySize, LDS_BYTES) != hipSuccess) { fprintf(stderr, "kernel_launch: hipFuncSetAttribute failed\n"); grid = -1; return; }
        if (hipOccupancyMaxActiveBlocksPerMultiprocessor(&per_cu, (const void*)fwd_kernel, NTHR, LDS_BYTES) != hipSuccess || per_cu < 1) fprintf(stderr, "kernel_launch: occupancy query says %d\n", per_cu);
        (void)hipGetLastError();
        grid = cus;
        if (grid != 256) fprintf(stderr, "kernel_launch: %d CUs (built for 256)\n", grid);
    }
    if (grid < 0) return;
    if (hipMemsetAsync((char*)d_ws + WS_CTL, 0, CTL_ZERO_BYTES, stream) != hipSuccess) return;
    Args a{};
    for (int i = 0; i < 23; ++i) a.in[i] = (const float*)d_in[i];
    a.out = (float*)d_out; a.ws = (unsigned char*)d_ws;
#if MK_ONE_LAUNCH
    a.ph_lo = 0; a.ph_hi = NPHASE;
    hipLaunchKernelGGL(fwd_kernel, dim3(grid), dim3(NTHR), LDS_BYTES, stream, a);
#else
    for (int p = 0; p < NPHASE; ++p) { a.ph_lo = p; a.ph_hi = p + 1; hipLaunchKernelGGL(fwd_kernel, dim3(grid), dim3(NTHR), LDS_BYTES, stream, a); }
#endif
}
```

```cpp
#include <hip/hip_runtime.h>
#include <cstdio>
#include <cstdint>
#include <utility>

#ifndef PROBE_FLAGS
#define PROBE_FLAGS 0
#endif
#ifndef LEVEL
#define LEVEL 4
#endif
#ifndef MK_ONE_LAUNCH
#define MK_ONE_LAUNCH 1
#endif

#ifndef REPS
#define REPS {1,1,1,1,1,1,1,1,1,1}
#endif
#define GAS __attribute__((address_space(1)))
#define LAS __attribute__((address_space(3)))
typedef unsigned short bf16;
typedef unsigned v4u __attribute__((ext_vector_type(4)));
typedef unsigned v2u __attribute__((ext_vector_type(2)));
typedef float f32x4 __attribute__((ext_vector_type(4)));
typedef float f32x2 __attribute__((ext_vector_type(2)));
typedef short bf16x8 __attribute__((ext_vector_type(8)));
typedef GAS unsigned gu32;
#define RLX_AGENT __ATOMIC_RELAXED, __HIP_MEMORY_SCOPE_AGENT
#define LDS_WAIT() asm volatile("s_waitcnt lgkmcnt(0)" ::: "memory")
#define VM_WAIT() asm volatile("s_waitcnt vmcnt(0)" ::: "memory")

constexpr int NWAVES = 8, NTHR = 512;
constexpr int NB = 16, SEQ = 2048, D = 1024, T = NB * SEQ;
constexpr int DIN = 3592, NMAIN = 3584;
constexpr int DC = 512, CONVG = 64;
constexpr int NH = 4, HD = 128, DD = 512;
constexpr int CHK = 64, NCHUNK = SEQ / CHK, NCHUNK_ALL = NB * NH * NCHUNK;
constexpr int NE = 32, EPG = 8, NG = 4, DE = 256;
constexpr float LN_EPS = 1e-5f, RMS_EPS = 1e-6f;
constexpr float ALPHA = 1.18920711500272f;
constexpr int MAXROWS = T * 2 + NE * 256;

constexpr size_t MiB = 1u << 20;
constexpr size_t WS_CTL = 0, CTL_ZERO_BYTES = 1 * MiB;
constexpr size_t WS_MOD = 1 * MiB;
constexpr size_t WS_BA = 1 * MiB + 512 * 1024;
constexpr size_t WS_TOKE = 3 * MiB, WS_TOKR = 3 * MiB + 256 * 1024, WS_TOKG = 3 * MiB + 512 * 1024, WS_DEC = 3 * MiB + 768 * 1024;
constexpr size_t WS_ELIST = 4 * MiB;
constexpr size_t WS_WIN = 12 * MiB, WS_WOUT = 19 * MiB, WS_WGU = 21 * MiB, WS_WD = 53 * MiB;
constexpr size_t WS_R1 = 72 * MiB;
constexpr size_t WS_PBCU = 136 * MiB, WS_PQKV = 232 * MiB, WS_PZ = 328 * MiB;
constexpr size_t WS_DNW = 360 * MiB, WS_DNQ = 392 * MiB, WS_DNK = 424 * MiB, WS_DNG = 456 * MiB, WS_DNU = 472 * MiB;
constexpr size_t WS_MIX = 136 * MiB, WS_X1 = 232 * MiB, WS_HID = 136 * MiB, WS_YR = 360 * MiB;
constexpr size_t WS_END = 504 * MiB;
constexpr int CW_CNT = 64;
constexpr int CW_BAR = 4096;

constexpr int RING_OFF = 0, RING_BYTES = 131072;
constexpr int XTOK_OFF = 131072;
constexpr int LDSCTL_OFF = 147456, MISC_OFF = LDSCTL_OFF + 1024;
constexpr int LDS_BYTES = 155648;

typedef __bf16 bf16n2 __attribute__((ext_vector_type(2)));
__device__ __forceinline__ unsigned pk2(float lo, float hi) { const bf16n2 b = __builtin_convertvector((f32x2){lo, hi}, bf16n2); return __builtin_bit_cast(unsigned, b); }
__device__ __forceinline__ unsigned f2bf(float f) { return pk2(f, 0.f) & 0xffffu; }
__device__ __forceinline__ float bflo(unsigned w) { return __builtin_bit_cast(float, w << 16); }
__device__ __forceinline__ float bfhi(unsigned w) { return __builtin_bit_cast(float, w & 0xffff0000u); }
__device__ __forceinline__ float bf1(bf16 b) { return __builtin_bit_cast(float, ((unsigned)b) << 16); }
template <int CTRL, int ROWMASK>
__device__ __forceinline__ float dppf(float v) { return __builtin_bit_cast(float, __builtin_amdgcn_update_dpp(0, __builtin_bit_cast(int, v), CTRL, ROWMASK, 0xf, false)); }
__device__ __forceinline__ float sum4(float v) { v += dppf<0xB1, 0xf>(v); v += dppf<0x4E, 0xf>(v); return v; }
__device__ __forceinline__ float sum8(float v) { v = sum4(v); v += dppf<0x141, 0xf>(v); return v; }
__device__ __forceinline__ float sum16(float v) { v = sum8(v); v += dppf<0x140, 0xf>(v); return v; }
__device__ __forceinline__ float wave_sum(float v) {
    v = sum16(v); v += dppf<0x142, 0xa>(v); v += dppf<0x143, 0xc>(v);
    return __builtin_bit_cast(float, __builtin_amdgcn_readlane(__builtin_bit_cast(int, v), 63));
}
__device__ __forceinline__ float siluf(float x) { return x / (1.f + __expf(-x)); }

namespace pg8 {
#define PG8_LAS __attribute__((address_space(3)))
typedef unsigned short bf16_t;
typedef unsigned u32x4 __attribute__((ext_vector_type(4)));
constexpr int BM = 256, BK = 64, HALF = 128, HTB = HALF * BK * 2, STAGE_BYTES = 8 * HTB;

__host__ __device__ __forceinline__ int lds_byte(int r, int c) { const int st = (r >> 4) * 2 + (c >> 5), rr = r & 15, cc = c & 31, ob = rr * 64 + cc * 2; return st * 1024 + (ob ^ (((ob >> 9) & 1) << 5)); }
__host__ __device__ __forceinline__ void stage_rc(int b, int& R, int& C) { const int st = b / 1024, sb = b % 1024, swz = sb ^ (((sb >> 9) & 1) << 5); R = (st >> 1) * 16 + swz / 64; C = (st & 1) * 32 + (swz % 64) / 2; }
__host__ __device__ __forceinline__ int perm32(int rho) { const int n = rho >> 4, i = rho & 15; return 8 * (i >> 2) + 4 * n + (i & 3); }

struct Unit { const char* a; const char* b; int i0, i1, i2; };

__device__ __forceinline__ unsigned cvt_pk_bf16(float lo, float hi) { return pk2(lo, hi); }

template <class Epi, class Sched, bool ALIGN_EPI = false, bool SP2 = true>
__device__ __forceinline__ void gemm_phase(PG8_LAS unsigned char* lds, const int K, const Sched& S, const Epi& E) {
    const int tid = threadIdx.x, wid = __builtin_amdgcn_readfirstlane(tid >> 6), lane = tid & 63, wr = wid >> 2, wc = wid & 3, fr = lane & 15, fq = lane >> 4;
    const int nt = K / BK;
    int R[2], C[2];
    unsigned voffA[2][2], nvoffA[2][2], voffB[2];
#pragma unroll
    for (int i = 0; i < 2; ++i) { stage_rc(tid * 16 + i * 8192, R[i], C[i]); const int Rb = Epi::PERM ? ((R[i] & ~31) + perm32(R[i] & 31)) : R[i];
        voffB[i] = (unsigned)(Rb * K + C[i]) * 2u; }
    const size_t kstep = (size_t)(BK * 2);
    const size_t hstep = (size_t)HALF * K * 2;
    const unsigned ldsw = (unsigned)wid * 1024u;
    const int aoff = lds_byte(wr * 64 + fr, fq * 8), boff = lds_byte(wc * 32 + fr, fq * 8);
#define PG8_SA(b, h) (((b) * 2 + (h)) * HTB)
#define PG8_SB(b, h) ((4 + (b) * 2 + (h)) * HTB)
#define PG8_STAGEB(bufoff, gbase) do { _Pragma("unroll") for (int _i = 0; _i < 2; ++_i) \
        __builtin_amdgcn_global_load_lds((const unsigned*)((const char*)(gbase) + voffB[_i]), (PG8_LAS unsigned*)(lds + (bufoff) + ldsw + _i * 8192), 16, 0, 0); } while (0)
#define PG8_STAGEA(bufoff, gbase, vo, h) do { _Pragma("unroll") for (int _i = 0; _i < 2; ++_i) \
        __builtin_amdgcn_global_load_lds((const unsigned*)((const char*)(gbase) + (vo)[h][_i]), (PG8_LAS unsigned*)(lds + (bufoff) + ldsw + _i * 8192), 16, 0, 0); } while (0)
#define PG8_LDA(dst, b, h) do { _Pragma("unroll") for (int m = 0; m < 4; ++m) _Pragma("unroll") for (int k = 0; k < 2; ++k) dst[m][k] = *(const PG8_LAS bf16x8*)(lds + PG8_SA(b, h) + aoff + m * 2048 + k * 1024); } while (0)
#define PG8_LDB(dst, b, h) do { _Pragma("unroll") for (int n = 0; n < 2; ++n) _Pragma("unroll") for (int k = 0; k < 2; ++k) dst[n][k] = *(const PG8_LAS bf16x8*)(lds + PG8_SB(b, h) + boff + n * 2048 + k * 1024); } while (0)
#define PG8_MMA(ai, bj, At, Bt) do { __builtin_amdgcn_s_setprio(1); _Pragma("unroll") for (int m = 0; m < 4; ++m) _Pragma("unroll") for (int n = 0; n < 2; ++n) _Pragma("unroll") for (int k = 0; k < 2; ++k) \
        acc[ai][bj][m][n] = __builtin_amdgcn_mfma_f32_16x16x32_bf16(Bt[n][k], At[m][k], acc[ai][bj][m][n], 0, 0, 0); __builtin_amdgcn_s_setprio(0); } while (0)
#define PG8_WAIT_V(n) asm volatile("s_waitcnt vmcnt(" #n ")" ::: "memory")
#define PG8_WAIT_L(n) asm volatile("s_waitcnt lgkmcnt(" #n ")" ::: "memory")
#define PG8_BAR __builtin_amdgcn_s_barrier()
#define PG8_SCHED __builtin_amdgcn_sched_barrier(0)
    Unit cur, nxt; int ui = 0;
    if (!S.next(0, cur)) return;
    S.a_off(cur, 0, voffA, R, C, K);
    f32x4 acc[2][2][4][2];
#pragma unroll
    for (int a = 0; a < 2; ++a)
#pragma unroll
        for (int b = 0; b < 2; ++b)
#pragma unroll
            for (int m = 0; m < 4; ++m)
#pragma unroll
                for (int n = 0; n < 2; ++n) acc[a][b][m][n] = (f32x4){0.f, 0.f, 0.f, 0.f};
    bf16x8 At[4][2], B0[2][2], B1[2][2];
    const char* cA = cur.a; const char* cB = cur.b;
    static_assert(SP2, "only the SP2 loop is kept in this file");
    PG8_STAGEB(PG8_SB(0, 0), cB); PG8_STAGEB(PG8_SB(0, 1), cB + hstep); PG8_STAGEA(PG8_SA(0, 0), cA, voffA, 0); PG8_STAGEA(PG8_SA(0, 1), cA, voffA, 1);
    if (wr == 1) PG8_BAR;
    PG8_WAIT_V(2); PG8_BAR;
    PG8_STAGEB(PG8_SB(1, 0), cB + kstep); PG8_STAGEA(PG8_SA(1, 0), cA + kstep, voffA, 0); PG8_STAGEB(PG8_SB(1, 1), cB + hstep + kstep);
    PG8_WAIT_V(6); PG8_BAR;
    for (;;) {
        const bool has_next = S.next(ui + 1, nxt);
        const char* nA = has_next ? nxt.a : cA; const char* nB = has_next ? nxt.b : cB;
        if (Sched::GATHER && has_next) S.a_off(nxt, ui + 1, nvoffA, R, C, K);
        else {
#pragma unroll
            for (int h = 0; h < 2; ++h)
#pragma unroll
                for (int i = 0; i < 2; ++i) nvoffA[h][i] = voffA[h][i]; }
        for (int t = 0; t < nt; t += 2) {
            const bool last = (t == nt - 2);
            const char* a1 = cA + (size_t)(t + 1) * kstep;
            const char* a2 = last ? nA : cA + (size_t)(t + 2) * kstep; const char* b2 = last ? nB : cB + (size_t)(t + 2) * kstep;
            const char* a3 = a2 + kstep; const char* b3 = b2 + kstep;
            unsigned va2[2][2];
#pragma unroll
            for (int h = 0; h < 2; ++h)
#pragma unroll
                for (int i = 0; i < 2; ++i) va2[h][i] = (Sched::GATHER && last) ? nvoffA[h][i] : voffA[h][i];
            PG8_LDB(B0, 0, 0); PG8_LDB(B1, 0, 1); PG8_SCHED; PG8_LDA(At, 0, 0); PG8_STAGEA(PG8_SA(1, 1), a1, voffA, 1);
            PG8_WAIT_V(8); PG8_WAIT_L(0); PG8_BAR; PG8_MMA(0, 0, At, B0); PG8_MMA(0, 1, At, B1); PG8_BAR; PG8_SCHED;
            PG8_LDA(At, 0, 1); PG8_STAGEB(PG8_SB(0, 0), b2); PG8_STAGEB(PG8_SB(0, 1), b2 + hstep); PG8_STAGEA(PG8_SA(0, 0), a2, va2, 0);
            PG8_WAIT_V(8); PG8_WAIT_L(0); PG8_BAR; PG8_MMA(1, 0, At, B0); PG8_MMA(1, 1, At, B1); PG8_BAR; PG8_SCHED;
            PG8_LDB(B0, 1, 0); PG8_LDB(B1, 1, 1); PG8_SCHED; PG8_LDA(At, 1, 0); PG8_STAGEA(PG8_SA(0, 1), a2, va2, 1);
            PG8_WAIT_V(8); PG8_WAIT_L(0); PG8_BAR; PG8_MMA(0, 0, At, B0); PG8_MMA(0, 1, At, B1); PG8_BAR; PG8_SCHED;
            PG8_LDA(At, 1, 1); PG8_STAGEB(PG8_SB(1, 0), b3); PG8_STAGEB(PG8_SB(1, 1), b3 + hstep); PG8_STAGEA(PG8_SA(1, 0), a3, va2, 0);
            PG8_WAIT_V(8); PG8_WAIT_L(0); PG8_BAR; PG8_MMA(1, 0, At, B0); PG8_MMA(1, 1, At, B1); PG8_BAR; PG8_SCHED;
        }
        if constexpr (ALIGN_EPI) { if (wr == 0) PG8_BAR; }
        E(acc, cur, wr, wc, fr, fq);
        if (!has_next) break;
#pragma unroll
        for (int a = 0; a < 2; ++a)
#pragma unroll
            for (int b = 0; b < 2; ++b)
#pragma unroll
                for (int m = 0; m < 4; ++m)
#pragma unroll
                    for (int n = 0; n < 2; ++n) acc[a][b][m][n] = (f32x4){0.f, 0.f, 0.f, 0.f};
        cur = nxt; cA = nA; cB = nB; ++ui;
#pragma unroll
        for (int h = 0; h < 2; ++h)
#pragma unroll
            for (int i = 0; i < 2; ++i) voffA[h][i] = nvoffA[h][i];
        if constexpr (ALIGN_EPI) { if (wr == 1) PG8_BAR; }
    }
    PG8_WAIT_V(0);
    if constexpr (!ALIGN_EPI) { if (wr == 0) PG8_BAR; }
    PG8_BAR;
#undef PG8_SA
#undef PG8_SB
#undef PG8_STAGEA
#undef PG8_STAGEB
#undef PG8_LDA
#undef PG8_LDB
#undef PG8_MMA
#undef PG8_WAIT_V
#undef PG8_WAIT_L
#undef PG8_BAR
#undef PG8_SCHED
}

struct DenseOrder {
    static constexpr bool GATHER = false;
    const char* A; const char* Bt; int nM, nN, nwg, G, c, K;
    __device__ void init(const void* A_, const void* Bt_, int M, int N, int K_, int G_, int c_) { A = (const char*)A_; Bt = (const char*)Bt_; nM = M / BM; nN = N / BM; nwg = nM * nN; G = G_; c = c_; K = K_; }
    __device__ __forceinline__ bool next(int i, Unit& u) const {
        const long L = (long)i * G + c; if (L >= nwg) return false;
        int wgid = (int)L; { const int q = nwg / 8, r = nwg % 8, xcd = wgid % 8, off = wgid / 8; wgid = (xcd < r ? xcd * (q + 1) : r * (q + 1) + (xcd - r) * q) + off; }
        const int nig = 8 * nN, gid = wgid / nig, fm = gid * 8, gsz = (nM - fm) < 8 ? (nM - fm) : 8;
        const int pm = fm + ((wgid % nig) % gsz), pn = (wgid % nig) / gsz;
        u.a = A + (size_t)pm * BM * K * 2; u.b = Bt + (size_t)pn * BM * K * 2; u.i0 = pm; u.i1 = pn; u.i2 = 0; return true;
    }
    __device__ __forceinline__ void a_off(const Unit&, int, unsigned (&vo)[2][2], const int (&R)[2], const int (&C)[2], int K_) const {
#pragma unroll
        for (int h = 0; h < 2; ++h)
#pragma unroll
            for (int i = 0; i < 2; ++i) vo[h][i] = (unsigned)((h * HALF + R[i]) * K_ + C[i]) * 2u;
    }
};
}

#define XB_TMO      128
#define XB_XCNT(j)  (256  + 64 * (j))
#define XB_XSUB(j)  (1280 + 64 * (j))
#define XB_XGEN(j)  (2304 + 64 * (j))
#define XB_TOP      3328
#define XB_TOPGEN   3392
#define XCD_BAR_WORDS 3456
#define XB_SPIN_CAP (1u << 18)
__device__ __forceinline__ unsigned xb_ld(unsigned* p)              { return __hip_atomic_load(p, __ATOMIC_RELAXED, __HIP_MEMORY_SCOPE_AGENT); }
__device__ __forceinline__ unsigned xb_add(unsigned* p, unsigned v) { return __hip_atomic_fetch_add(p, v, __ATOMIC_RELAXED, __HIP_MEMORY_SCOPE_AGENT); }
__device__ __forceinline__ unsigned xb_xcc_id() { return (unsigned)__builtin_amdgcn_s_getreg((3 << 11) | 20) & 0xFu; }
#define XB_SPIN(cond, bar) do { unsigned _sp = 0; while (cond) { __builtin_amdgcn_s_sleep(1); \
    if ((++_sp & 255u) == 0u) { if (xb_ld(&(bar)[XB_TMO])) break; if (_sp > XB_SPIN_CAP) { atomicAdd(&(bar)[XB_TMO], 1u); break; } } } } while (0)
struct XcdBarrier { unsigned* bar; unsigned x; volatile LAS unsigned* st; };
__device__ __forceinline__ XcdBarrier xcd_barrier_post(unsigned* bar, volatile LAS unsigned* st) {
    XcdBarrier b; b.bar = bar; b.x = xb_xcc_id(); b.st = st;
    if (threadIdx.x == 0) (void)xb_add(&bar[XB_XCNT(b.x)], 1u);
    return b;
}
__device__ __forceinline__ void xcd_barrier_complete(unsigned* bar, unsigned x, unsigned& nloc, unsigned& nx) {
    const unsigned G = gridDim.x * gridDim.y * gridDim.z;
    unsigned sum, cnt, mine, sp = 0u;
    for (;;) {
        sum = 0u; cnt = 0u; mine = 0u;
#pragma unroll
        for (unsigned j = 0; j < 16; ++j) { const unsigned c = xb_ld(&bar[XB_XCNT(j)]); sum += c; cnt += (c > 0u) ? 1u : 0u; mine = (j == x) ? c : mine; }
        if (sum == G) break;
        __builtin_amdgcn_s_sleep(1);
        if ((++sp & 255u) == 0u) { if (xb_ld(&bar[XB_TMO])) break; if (sp > XB_SPIN_CAP) { atomicAdd(&bar[XB_TMO], 1u); break; } }
    }
    nloc = mine > 0u ? mine : 1u; nx = cnt > 0u ? cnt : 1u;
}
__device__ __forceinline__ void xcd_barrier(const XcdBarrier& b) {
    asm volatile("s_waitcnt vmcnt(0)" ::: "memory");
    __syncthreads();
    if (threadIdx.x == 0) {
        unsigned* bar = b.bar;
        __builtin_amdgcn_s_waitcnt(0);
        unsigned nloc = b.st[0], nx = b.st[1];
        if (nloc == 0u) { xcd_barrier_complete(bar, b.x, nloc, nx); b.st[0] = nloc; b.st[1] = nx; }
        const unsigned old = xb_add(&bar[XB_XSUB(b.x)], 1u);
        const unsigned gen = old / nloc;
        if (old + 1u == (gen + 1u) * nloc) {
            __builtin_amdgcn_fence(__ATOMIC_RELEASE, "agent");
            asm volatile("s_waitcnt vmcnt(0)" ::: "memory");
            const unsigned og = xb_add(&bar[XB_TOP], 1u);
            const unsigned tg = og / nx;
            if (og + 1u == (tg + 1u) * nx) xb_add(&bar[XB_TOPGEN], 1u);
            else XB_SPIN(xb_ld(&bar[XB_TOPGEN]) == tg, bar);
            __builtin_amdgcn_fence(__ATOMIC_ACQUIRE, "agent");
            xb_add(&bar[XB_XGEN(b.x)], 1u);
            asm volatile("s_waitcnt vmcnt(0)" ::: "memory");
        } else {
            XB_SPIN(xb_ld(&bar[XB_XGEN(b.x)]) == gen, bar);
            __builtin_amdgcn_fence(__ATOMIC_ACQUIRE, "agent");
            asm volatile("s_waitcnt vmcnt(0)" ::: "memory");
        }
    }
    __syncthreads();
}

struct Frame {
    LAS unsigned char* lds;
    int tid, lane, wave, vcu, G;
    const float *x, *c, *w_ada, *b_ada, *w_in, *conv_w, *conv_norm_w, *dn_conv_w, *dn_A_log, *dn_dt_bias, *dn_norm_w, *w_out, *ln1_g, *ln1_b,
                *w_grp, *b_grp, *w_exp, *b_exp, *w_gate, *w_up, *w_down, *ln2_g, *ln2_b;
    float* out; unsigned char* ws; int flags;
};

__device__ __forceinline__ void transpose_item(const float* W, int ldw, int k0, int n0, bf16* WT, int ldt, int drow0, LAS float* scr, int lane) {
#pragma unroll 8
    for (int i = 0; i < 32; ++i) { const int kk = 2 * i + (lane >> 5); scr[kk * 33 + (lane & 31)] = W[(size_t)(k0 + kk) * ldw + n0 + (lane & 31)]; }
    LDS_WAIT(); asm volatile("" ::: "memory");
    const int c = lane & 7;
#pragma unroll
    for (int j = 0; j < 4; ++j) { const int n = (lane >> 3) + 8 * j; const LAS float* s = scr + (8 * c) * 33 + n;
        v4u o; o.x = pk2(s[0 * 33], s[1 * 33]); o.y = pk2(s[2 * 33], s[3 * 33]); o.z = pk2(s[4 * 33], s[5 * 33]); o.w = pk2(s[6 * 33], s[7 * 33]);
        *(GAS v4u*)(WT + (size_t)(drow0 + n) * ldt + k0 + 8 * c) = o; }
    LDS_WAIT(); asm volatile("" ::: "memory");
}
__device__ __forceinline__ void p0_prologue(Frame& F) {
#ifdef EXP_FILL
    {
        const size_t gt = (size_t)blockIdx.x * NTHR + F.tid, gn = (size_t)F.G * NTHR;
        GAS v4u* w0 = (GAS v4u*)(F.ws + (3 * MiB) / 2); for (size_t i = gt; i < (12 * MiB - (3 * MiB) / 2) / 16; i += gn) w0[i] = (v4u){0u, 0u, 0u, 0u};
        GAS v4u* w1 = (GAS v4u*)(F.ws + 72 * MiB); for (size_t i = gt; i < (432 * MiB) / 16; i += gn) w1[i] = (v4u){0u, 0u, 0u, 0u};
    }
#endif
    if (blockIdx.x < 96) {
        LAS float* sc = (LAS float*)(F.lds);
        LAS float* red = (LAS float*)(F.lds + 65536);
#pragma unroll
        for (int it = 0; it < 8; ++it) { const int i4 = F.tid + NTHR * it, b = i4 >> 8, k = (i4 & 255) * 4; const f32x4 v = *(const f32x4*)(F.c + 4 * i4);
            sc[k * 16 + b] = siluf(v.x); sc[(k + 1) * 16 + b] = siluf(v.y); sc[(k + 2) * 16 + b] = siluf(v.z); sc[(k + 3) * 16 + b] = siluf(v.w); }
        __syncthreads();
        const int col = blockIdx.x * 64 + F.lane, kbeg = F.wave * 128;
        float acc[16];
#pragma unroll
        for (int b = 0; b < 16; ++b) acc[b] = 0.f;
#pragma unroll 4
        for (int k = kbeg; k < kbeg + 128; ++k) {
            const float w = F.w_ada[(size_t)k * 6144 + col];
            const LAS f32x4* s4 = (const LAS f32x4*)(sc + k * 16);
#pragma unroll
            for (int q = 0; q < 4; ++q) { const f32x4 s = s4[q]; acc[4 * q] += s.x * w; acc[4 * q + 1] += s.y * w; acc[4 * q + 2] += s.z * w; acc[4 * q + 3] += s.w * w; }
        }
#pragma unroll
        for (int b = 0; b < 16; ++b) red[(F.wave * 16 + b) * 64 + F.lane] = acc[b];
        __syncthreads();
        for (int o = F.tid; o < 1024; o += NTHR) { const int b = o >> 6, l = o & 63; float s = 0.f;
#pragma unroll
            for (int w = 0; w < 8; ++w) s += red[(w * 16 + b) * 64 + l];
            const int cc = blockIdx.x * 64 + l;
            ((float*)(F.ws + WS_MOD))[b * 6144 + cc] = s + F.b_ada[cc]; }
        __syncthreads();
    }
    LAS float* scr = (LAS float*)(F.lds + F.wave * 16384);
    const int gw = F.vcu * NWAVES + F.wave, NGW = F.G * NWAVES;
    constexpr int I_IN = 16 * (NMAIN / 32), I_OUT = 16 * 32, I_G = NE * 16 * 8, I_D = NE * 4 * 32;
    constexpr int NITEMS = I_IN + I_OUT + 2 * I_G + I_D;
    bf16* WIN = (bf16*)(F.ws + WS_WIN); bf16* WOUT = (bf16*)(F.ws + WS_WOUT); bf16* WGU = (bf16*)(F.ws + WS_WGU); bf16* WD = (bf16*)(F.ws + WS_WD);
    for (int it = gw; it < NITEMS; it += NGW) {
        int r = it;
        if (r < I_IN) { const int kb = r / (NMAIN / 32), nb = r % (NMAIN / 32); transpose_item(F.w_in, DIN, 64 * kb, 32 * nb, WIN, D, 32 * nb, scr, F.lane); continue; } r -= I_IN;
        if (r < I_OUT) { const int kb = r / 32, nb = r % 32; transpose_item(F.w_out, D, 64 * kb, 32 * nb, WOUT, D, 32 * nb, scr, F.lane); continue; } r -= I_OUT;
        if (r < 2 * I_G) { const int up = r / I_G; r -= up * I_G; const int e = r / 128, kb = (r % 128) / 8, nb = r % 8, n0 = 32 * nb;
            transpose_item((up ? F.w_up : F.w_gate) + (size_t)e * D * DE, DE, 64 * kb, n0, WGU + (size_t)e * 512 * D, D, (n0 / 128) * 256 + up * 128 + (n0 % 128), scr, F.lane); continue; } r -= 2 * I_G;
        { const int e = r / 128, kb = (r % 128) / 32, nb = r % 32; transpose_item(F.w_down + (size_t)e * DE * D, D, 64 * kb, 32 * nb, WD + (size_t)e * D * DE, DE, 32 * nb, scr, F.lane); }
    }
}

__device__ __forceinline__ void p1_modulate(Frame& F) {
    LAS float* wx = (LAS float*)(F.lds);
#pragma unroll
    for (int it = 0; it < 4; ++it) { const int i4 = F.tid + NTHR * it, k = i4 >> 1, hf = i4 & 1, j = k >> 8, l = (k >> 2) & 63, e = k & 3;
        *(LAS f32x4*)(wx + ((hf * 16 + (j * 4 + e)) * 64 + l) * 4) = *(const f32x4*)(F.w_in + (size_t)k * DIN + NMAIN + 4 * hf); }
    __syncthreads();
    const float* MOD = (const float*)(F.ws + WS_MOD);
    bf16* H1 = (bf16*)(F.ws + WS_R1); float* BA = (float*)(F.ws + WS_BA);
    for (int gw = F.vcu * NWAVES + F.wave; gw < T / 16; gw += F.G * NWAVES) {
    const int m0 = gw * 16, b = m0 >> 11;
    f32x4 sc[4], sh[4];
#pragma unroll
    for (int j = 0; j < 4; ++j) { sh[j] = *(const f32x4*)(MOD + b * 6144 + 256 * j + 4 * F.lane); sc[j] = *(const f32x4*)(MOD + b * 6144 + D + 256 * j + 4 * F.lane); }
    for (int r = 0; r < 16; ++r) {
        const int m = m0 + r;
        const GAS f32x4* xr = (const GAS f32x4*)(F.x + (size_t)m * D) + F.lane;
        f32x4 h[4];
#pragma unroll
        for (int j = 0; j < 4; ++j) { const f32x4 v = xr[64 * j]; h[j] = v * (sc[j] + 1.0f) + sh[j]; }
        GAS unsigned long long* o8 = (GAS unsigned long long*)(H1 + (size_t)m * D) + F.lane;
#pragma unroll
        for (int j = 0; j < 4; ++j) o8[64 * j] = (unsigned long long)pk2(h[j].x, h[j].y) | ((unsigned long long)pk2(h[j].z, h[j].w) << 32);
        float a[8];
#pragma unroll
        for (int o = 0; o < 8; ++o) a[o] = 0.f;
#pragma unroll
        for (int j = 0; j < 4; ++j)
#pragma unroll
            for (int e = 0; e < 4; ++e) { const float hv = h[j][e];
                const f32x4 w0 = *(const LAS f32x4*)(wx + ((0 * 16 + (j * 4 + e)) * 64 + F.lane) * 4), w1 = *(const LAS f32x4*)(wx + ((1 * 16 + (j * 4 + e)) * 64 + F.lane) * 4);
                a[0] += hv * w0.x; a[1] += hv * w0.y; a[2] += hv * w0.z; a[3] += hv * w0.w; a[4] += hv * w1.x; a[5] += hv * w1.y; a[6] += hv * w1.z; a[7] += hv * w1.w; }
#pragma unroll
        for (int o = 0; o < 8; ++o) a[o] = wave_sum(a[o]);
        if (F.lane == 0) { *(f32x4*)(BA + (size_t)m * 8) = (f32x4){a[0], a[1], a[2], a[3]}; *(f32x4*)(BA + (size_t)m * 8 + 4) = (f32x4){a[4], a[5], a[6], a[7]}; }
    }
    }
}

struct EpiP {
    static constexpr bool PERM = true;
    unsigned char* ws;
    __device__ __forceinline__ void operator()(const f32x4 (&acc)[2][2][4][2], const pg8::Unit& u, int wr, int wc, int fr, int fq) const {
        const int pm = u.i0, pn = u.i1;
        bf16* base; int ldc, colt;
        if (pn < 6) { base = (bf16*)(ws + WS_PBCU); ldc = 1536; colt = pn * 256; }
        else if (pn < 12) { base = (bf16*)(ws + WS_PQKV); ldc = 1536; colt = (pn - 6) * 256; }
        else { base = (bf16*)(ws + WS_PZ); ldc = 512; colt = (pn - 12) * 256; }
        const int row0 = pm * 256 + wr * 64 + fr, col0 = colt + wc * 32 + 8 * fq;
#pragma unroll
        for (int ai = 0; ai < 2; ++ai)
#pragma unroll
            for (int m = 0; m < 4; ++m) { bf16* rowp = base + (size_t)(row0 + ai * 128 + m * 16) * ldc + col0;
#pragma unroll
                for (int bj = 0; bj < 2; ++bj) { const f32x4 v0 = acc[ai][bj][m][0], v1 = acc[ai][bj][m][1];
                    v4u w; w.x = pg8::cvt_pk_bf16(v0[0], v0[1]); w.y = pg8::cvt_pk_bf16(v0[2], v0[3]); w.z = pg8::cvt_pk_bf16(v1[0], v1[1]); w.w = pg8::cvt_pk_bf16(v1[2], v1[3]);
                    *(v4u*)(rowp + bj * 128) = w; } }
    }
};
struct EpiBf {
    static constexpr bool PERM = true;
    bf16* O; int ldc;
    __device__ __forceinline__ void operator()(const f32x4 (&acc)[2][2][4][2], const pg8::Unit& u, int wr, int wc, int fr, int fq) const {
        const int row0 = u.i0 * 256 + wr * 64 + fr, col0 = u.i1 * 256 + wc * 32 + 8 * fq;
#pragma unroll
        for (int ai = 0; ai < 2; ++ai)
#pragma unroll
            for (int m = 0; m < 4; ++m) { bf16* rowp = O + (size_t)(row0 + ai * 128 + m * 16) * ldc + col0;
#pragma unroll
                for (int bj = 0; bj < 2; ++bj) { const f32x4 v0 = acc[ai][bj][m][0], v1 = acc[ai][bj][m][1];
                    v4u w; w.x = pg8::cvt_pk_bf16(v0[0], v0[1]); w.y = pg8::cvt_pk_bf16(v0[2], v0[3]); w.z = pg8::cvt_pk_bf16(v1[0], v1[1]); w.w = pg8::cvt_pk_bf16(v1[2], v1[3]);
                    *(v4u*)(rowp + bj * 128) = w; } }
    }
};

__device__ __forceinline__ void unpack8(const v4u w, float (&f)[8]) { f[0] = bflo(w.x); f[1] = bfhi(w.x); f[2] = bflo(w.y); f[3] = bfhi(w.y); f[4] = bflo(w.z); f[5] = bfhi(w.z); f[6] = bflo(w.w); f[7] = bfhi(w.w); }
__device__ __forceinline__ void p3a_convmix(Frame& F, const int gw0, const int ngw) {
    const bf16* P = (const bf16*)(F.ws + WS_PBCU); bf16* Y = (bf16*)(F.ws + WS_R1);
    const int ch = 8 * F.lane;
    float w0[8], w1[8], w2[8], nw[8];
#pragma unroll
    for (int e = 0; e < 8; ++e) { w0[e] = F.conv_w[ch + e]; w1[e] = F.conv_w[DC + ch + e]; w2[e] = F.conv_w[2 * DC + ch + e]; nw[e] = F.conv_norm_w[ch + e]; }
    for (int gw = gw0; gw < T / 16; gw += ngw) {
    const int m0 = gw * 16, t0 = m0 & (SEQ - 1);
    float p1[8], p2[8];
#pragma unroll
    for (int e = 0; e < 8; ++e) { p1[e] = 0.f; p2[e] = 0.f; }
    if (t0 != 0) {
        float c1[8], u1[8], c2[8], u2[8];
        unpack8(*(const GAS v4u*)(P + (size_t)(m0 - 1) * 1536 + 512 + ch), c1); unpack8(*(const GAS v4u*)(P + (size_t)(m0 - 1) * 1536 + 1024 + ch), u1);
        unpack8(*(const GAS v4u*)(P + (size_t)(m0 - 2) * 1536 + 512 + ch), c2); unpack8(*(const GAS v4u*)(P + (size_t)(m0 - 2) * 1536 + 1024 + ch), u2);
#pragma unroll
        for (int e = 0; e < 8; ++e) { p1[e] = c1[e] * u1[e]; p2[e] = c2[e] * u2[e]; }
    }
#pragma unroll 4
    for (int r = 0; r < 16; ++r) {
        const int m = m0 + r;
        float bb[8], cc[8], uu[8];
        unpack8(*(const GAS v4u*)(P + (size_t)m * 1536 + ch), bb); unpack8(*(const GAS v4u*)(P + (size_t)m * 1536 + 512 + ch), cc); unpack8(*(const GAS v4u*)(P + (size_t)m * 1536 + 1024 + ch), uu);
        float y[8]; float ss = 0.f;
#pragma unroll
        for (int e = 0; e < 8; ++e) { const float cu = cc[e] * uu[e]; y[e] = bb[e] * (w0[e] * p2[e] + w1[e] * p1[e] + w2[e] * cu); p2[e] = p1[e]; p1[e] = cu; ss += y[e] * y[e]; }
        ss = sum8(ss);
        const float rr = 1.0f / sqrtf(ss * (1.0f / 64.0f) + RMS_EPS);
        v4u o; o.x = pk2(y[0] * rr * nw[0], y[1] * rr * nw[1]); o.y = pk2(y[2] * rr * nw[2], y[3] * rr * nw[3]); o.z = pk2(y[4] * rr * nw[4], y[5] * rr * nw[5]); o.w = pk2(y[6] * rr * nw[6], y[7] * rr * nw[7]);
        *(GAS v4u*)(Y + (size_t)m * D + ch) = o;
    }
    }
}
#if LEVEL < 3
__device__ __forceinline__ void zero_ydelta(Frame& F) {
    bf16* Y = (bf16*)(F.ws + WS_R1);
    for (int gw = F.vcu * NWAVES + F.wave; gw < T / 16; gw += F.G * NWAVES)
    for (int r = 0; r < 16; ++r) { const int m = gw * 16 + r; *(GAS v4u*)(Y + (size_t)m * D + 512 + 8 * F.lane) = (v4u){0u, 0u, 0u, 0u}; }
}
#endif

__device__ __forceinline__ int kpos(int x) { const int n = x & 31; return (x & ~31) | (n < 16 ? 8 * (n >> 2) + (n & 3) : 8 * ((n - 16) >> 2) + 4 + (n & 3)); }
constexpr int PL_KB = 0, PL_QB = 17408, PL_VB = 34816, PL_KT = 52224, PL_AB = 70656, PL_AF = 79872, PL_DB = 83968, PL_SM = 86528;
__device__ __forceinline__ bf16x8 ldfrag(const LAS unsigned char* base, int stride, int row, int s, int q);
__device__ __forceinline__ bf16x8 pack8(const f32x4 a, const f32x4 b);
__device__ __forceinline__ void dn_pre(Frame& F) {
    LAS unsigned char* L = F.lds;
    LAS float* sgc = (LAS float*)(L + PL_SM);
    LAS float* sbeta = sgc + 64;
    LAS float* seg = sbeta + 64;
    LAS float* seke = seg + 64;
    const bf16* PQ = (const bf16*)(F.ws + WS_PQKV); const float* BA = (const float*)(F.ws + WS_BA);
    int tid = threadIdx.x; asm volatile("" : "+v"(tid));
    const int lane = tid & 63, wave = F.wave, col = lane & 15, q = lane >> 4;
    const f32x4 zero4 = (f32x4){0.f, 0.f, 0.f, 0.f};
    for (int cid = F.vcu; cid < NCHUNK_ALL; cid += F.G) {
        const int b = cid >> 7, h = (cid >> 5) & 3, n = cid & 31;
        const int mbase = b * SEQ + n * CHK;
        if (tid < 384) {
            const int g8 = tid % 48, seg8 = tid / 48, part = g8 >> 4, cc = (g8 & 15) * 8, gcol = part * 512 + h * HD + cc;
            float w[4][8];
#pragma unroll
            for (int k = 0; k < 4; ++k)
#pragma unroll
                for (int e = 0; e < 8; ++e) w[k][e] = F.dn_conv_w[k * 1536 + gcol + e];
            const int ts = seg8 * 8;
            v4u raw[11];
#pragma unroll
            for (int i = 0; i < 11; ++i) { const int t = ts - 3 + i; raw[i] = (n * CHK + t >= 0) ? *(const GAS v4u*)(PQ + (size_t)(mbase + t) * 1536 + gcol) : (v4u){0u, 0u, 0u, 0u}; }
            LAS unsigned char* dst = L + (part == 0 ? PL_QB : (part == 1 ? PL_KB : PL_VB)) + cc * 2;
#pragma unroll
            for (int hf = 0; hf < 2; ++hf) {
                float o[4][8];
#pragma unroll
                for (int t4 = 0; t4 < 4; ++t4) { const int tt = 4 * hf + t4; float r0[8], r1[8], r2[8], r3[8]; unpack8(raw[tt], r0); unpack8(raw[tt + 1], r1); unpack8(raw[tt + 2], r2); unpack8(raw[tt + 3], r3);
#pragma unroll
                    for (int e = 0; e < 8; ++e) o[t4][e] = siluf(w[0][e] * r0[e] + w[1][e] * r1[e] + w[2][e] * r2[e] + w[3][e] * r3[e]); }
                if (part < 2) {
#pragma unroll
                    for (int t4 = 0; t4 < 4; ++t4) { float ss = 0.f;
#pragma unroll
                        for (int e = 0; e < 8; ++e) ss += o[t4][e] * o[t4][e];
                        ss = sum16(ss);
                        const float rs = (1.0f / sqrtf(ss + RMS_EPS)) * (part == 0 ? 0.08838834764831845f : 1.0f);
#pragma unroll
                        for (int e = 0; e < 8; ++e) o[t4][e] *= rs; }
                }
#pragma unroll
                for (int t4 = 0; t4 < 4; ++t4) *(LAS v4u*)(dst + (ts + 4 * hf + t4) * 272) = (v4u){pk2(o[t4][0], o[t4][1]), pk2(o[t4][2], o[t4][3]), pk2(o[t4][4], o[t4][5]), pk2(o[t4][6], o[t4][7])};
                if (part == 1) {
#pragma unroll
                    for (int e = 0; e < 8; ++e) *(LAS v2u*)(L + PL_KT + (cc + e) * 144 + (ts + 4 * hf) * 2) = (v2u){pk2(o[0][e], o[1][e]), pk2(o[2][e], o[3][e])};
                }
                asm volatile("" ::: "memory");
            }
        } else if (tid < 448) {
            const int i = lane;
            const float bl = BA[(size_t)(mbase + i) * 8 + h], al = BA[(size_t)(mbase + i) * 8 + 4 + h];
            const float beta = 1.0f / (1.0f + __expf(-bl));
            const float xx = al + F.dn_dt_bias[h];
            const float sp = xx > 20.f ? xx : log1pf(__expf(xx));
            float v = -__expf(F.dn_A_log[h]) * sp;
#pragma unroll
            for (int o = 1; o < 64; o <<= 1) { const float tq = __shfl_up(v, o); if (i >= o) v += tq; }
            const float g63 = __shfl(v, 63);
            sgc[i] = v; sbeta[i] = beta; seg[i] = __expf(v); seke[i] = __expf(g63 - v);
            if (i == 63) ((float*)(F.ws + WS_DEC))[cid] = __expf(v);
        }
        __syncthreads();
        bf16* G = (bf16*)(F.ws + WS_DNG) + (size_t)cid * 4096;
#pragma unroll 1
        for (int task = wave; task < 20; task += 8) {
            const int isq = task >= 10 ? 1 : 0, tt = task - 10 * isq;
            int ti = 0; while (((ti + 1) * (ti + 2)) / 2 <= tt) ++ti;
            const int tj = tt - (ti * (ti + 1)) / 2;
            const LAS unsigned char* arow = L + (isq ? PL_QB : PL_KB) + (16 * ti + col) * 272 + 16 * q;
            const LAS unsigned char* brow = L + PL_KB + (16 * tj + col) * 272 + 16 * q;
            f32x4 acc = zero4;
#pragma unroll
            for (int s = 0; s < 4; ++s) acc = __builtin_amdgcn_mfma_f32_16x16x32_bf16(*(const LAS bf16x8*)(arow + 64 * s), *(const LAS bf16x8*)(brow + 64 * s), acc, 0, 0, 0);
            const int j = 16 * tj + col; const float gj = sgc[j];
#pragma unroll
            for (int r = 0; r < 4; ++r) { const int i = 16 * ti + 4 * q + r; const float dcy = __expf(sgc[i] - gj);
                if (isq) { G[i * 64 + kpos(j)] = (bf16)f2bf(i >= j ? acc[r] * dcy : 0.f); }
                else { const float a = (i > j) ? sbeta[i] * acc[r] * dcy : 0.f;
                    if (ti == tj) { *(LAS float*)(L + PL_AF + ti * 1024 + ((4 * q + r) * 16 + col) * 4) = a; *(LAS bf16*)(L + PL_AB + i * 144 + kpos(j) * 2) = (bf16)0; }
                    else *(LAS bf16*)(L + PL_AB + i * 144 + kpos(j) * 2) = (bf16)f2bf(a); } }
        }
        if (wave >= 4 && wave < 7) {
#pragma unroll
            for (int z = 0; z < 2; ++z) { const int uidx = (wave - 4) * 2 + z; const int ti = uidx < 3 ? 0 : (uidx < 5 ? 1 : 2), tj = uidx < 3 ? uidx + 1 : (uidx < 5 ? uidx - 1 : 3);
#pragma unroll
                for (int r = 0; r < 4; ++r) G[(16 * ti + 4 * q + r) * 64 + kpos(16 * tj + col)] = (bf16)0; }
        }
        { bf16* Q = (bf16*)(F.ws + WS_DNQ) + (size_t)cid * 8192; bf16* KT = (bf16*)(F.ws + WS_DNK) + (size_t)cid * 8192;
#pragma unroll
          for (int r = 0; r < 2; ++r) { const int p = tid + 512 * r, i = p >> 4, c16 = p & 15; float f[8]; unpack8(*(const LAS v4u*)(L + PL_QB + i * 272 + c16 * 16), f); const float sc = seg[i];
              *(GAS v2u*)(Q + i * 128 + kpos(c16 * 8)) = (v2u){pk2(f[0] * sc, f[1] * sc), pk2(f[2] * sc, f[3] * sc)}; *(GAS v2u*)(Q + i * 128 + kpos(c16 * 8 + 4)) = (v2u){pk2(f[4] * sc, f[5] * sc), pk2(f[6] * sc, f[7] * sc)}; }
#pragma unroll
          for (int r = 0; r < 2; ++r) { const int p = tid + 512 * r, d = p >> 3, t8 = p & 7; float f[8]; unpack8(*(const LAS v4u*)(L + PL_KT + d * 144 + t8 * 16), f);
              const f32x4 e0 = *(const LAS f32x4*)(seke + t8 * 8), e1 = *(const LAS f32x4*)(seke + t8 * 8 + 4);
              *(GAS v2u*)(KT + d * 64 + kpos(t8 * 8)) = (v2u){pk2(f[0] * e0.x, f[1] * e0.y), pk2(f[2] * e0.z, f[3] * e0.w)}; *(GAS v2u*)(KT + d * 64 + kpos(t8 * 8 + 4)) = (v2u){pk2(f[4] * e1.x, f[5] * e1.y), pk2(f[6] * e1.z, f[7] * e1.w)}; } }
        __syncthreads();
        if (wave == 0) {
            const int blk = q, c = col; const LAS float* Ab_ = (const LAS float*)(L + PL_AF + blk * 1024);
            float x[16];
#pragma unroll
            for (int r = 0; r < 16; ++r) { float acc = (r == c) ? 1.0f : 0.0f;
#pragma unroll
                for (int jb = 0; jb < (r + 3) / 4; ++jb) { const f32x4 a = *(const LAS f32x4*)(Ab_ + r * 16 + 4 * jb);
#pragma unroll
                    for (int e = 0; e < 4; ++e) if (4 * jb + e < r) acc -= a[e] * x[4 * jb + e]; }
                x[r] = acc; *(LAS bf16*)(L + PL_DB + blk * 640 + r * 40 + c * 2) = (bf16)f2bf(acc); }
        }
        __syncthreads();
        {
            bf16x8 Dfr[4];
#pragma unroll
            for (int i = 0; i < 4; ++i) { const v2u lo = *(const LAS v2u*)(L + PL_DB + i * 640 + col * 40 + 8 * q); Dfr[i] = __builtin_bit_cast(bf16x8, (v4u){lo.x, lo.y, 0u, 0u}); }
            bf16* U = (bf16*)(F.ws + WS_DNU) + (size_t)cid * 8192;
#pragma unroll
            for (int c2 = 0; c2 < 2; ++c2) {
                const int ct = 2 * wave + c2, isw = ct >= 8 ? 1 : 0, d = (16 * ct + col) & 127;
                const LAS unsigned char* src = L + (isw ? PL_KB : PL_VB) + d * 2;
                f32x4 rhs[4];
#pragma unroll
                for (int i = 0; i < 4; ++i) { const f32x4 bt = *(const LAS f32x4*)(sbeta + 16 * i + 4 * q), eg = *(const LAS f32x4*)(seg + 16 * i + 4 * q);
#pragma unroll
                    for (int r = 0; r < 4; ++r) rhs[i][r] = bf1(*(const LAS bf16*)(src + (16 * i + 4 * q + r) * 272)) * bt[r] * (isw ? eg[r] : 1.0f); }
                f32x4 X[4];
                X[0] = __builtin_amdgcn_mfma_f32_16x16x32_bf16(Dfr[0], pack8(rhs[0], zero4), zero4, 0, 0, 0);
                f32x4 y = __builtin_amdgcn_mfma_f32_16x16x32_bf16(ldfrag(L + PL_AB, 144, 16 + col, 0, q), pack8(X[0], zero4), zero4, 0, 0, 0);
                X[1] = __builtin_amdgcn_mfma_f32_16x16x32_bf16(Dfr[1], pack8(rhs[1] - y, zero4), zero4, 0, 0, 0);
                const bf16x8 X01 = pack8(X[0], X[1]);
                y = __builtin_amdgcn_mfma_f32_16x16x32_bf16(ldfrag(L + PL_AB, 144, 32 + col, 0, q), X01, zero4, 0, 0, 0);
                X[2] = __builtin_amdgcn_mfma_f32_16x16x32_bf16(Dfr[2], pack8(rhs[2] - y, zero4), zero4, 0, 0, 0);
                y = __builtin_amdgcn_mfma_f32_16x16x32_bf16(ldfrag(L + PL_AB, 144, 48 + col, 0, q), X01, zero4, 0, 0, 0);
                y = __builtin_amdgcn_mfma_f32_16x16x32_bf16(ldfrag(L + PL_AB, 144, 48 + col, 1, q), pack8(X[2], zero4), y, 0, 0, 0);
                X[3] = __builtin_amdgcn_mfma_f32_16x16x32_bf16(Dfr[3], pack8(rhs[3] - y, zero4), zero4, 0, 0, 0);
                if (!isw) {
#pragma unroll
                    for (int i = 0; i < 4; ++i) *(GAS v2u*)(U + (16 * ct + col) * 64 + 16 * i + 4 * q) = (v2u){pk2(X[i][0], X[i][1]), pk2(X[i][2], X[i][3])};
                } else {
#pragma unroll
                    for (int i = 0; i < 4; ++i)
#pragma unroll
                        for (int r = 0; r < 4; ++r) *(LAS bf16*)(L + PL_QB + (16 * i + 4 * q + r) * 272 + kpos(d) * 2) = (bf16)f2bf(X[i][r]);
                }
            }
        }
        __syncthreads();
        { bf16* W = (bf16*)(F.ws + WS_DNW) + (size_t)cid * 8192;
#pragma unroll
          for (int r = 0; r < 2; ++r) { const int p = tid + 512 * r, i = p >> 4, c16 = p & 15; *(GAS v4u*)(W + i * 128 + c16 * 8) = *(const LAS v4u*)(L + PL_QB + i * 272 + c16 * 16); } }
        __syncthreads();
    }
}

__device__ __forceinline__ bf16x8 pack8(const f32x4 a, const f32x4 b) {
    const v4u w = (v4u){pg8::cvt_pk_bf16(a.x, a.y), pg8::cvt_pk_bf16(a.z, a.w), pg8::cvt_pk_bf16(b.x, b.y), pg8::cvt_pk_bf16(b.z, b.w)};
    return __builtin_bit_cast(bf16x8, w);
}
__device__ __forceinline__ bf16x8 ldfrag(const LAS unsigned char* base, int stride, int row, int s, int q) {
    return *(const LAS bf16x8*)(base + row * stride + 64 * s + 16 * q);
}
__device__ __forceinline__ void dn_scan(Frame& F) {
    if (blockIdx.x >= NB * NH) return;
    const int item = blockIdx.x, b = item >> 2, h = item & 3;
    int tid = threadIdx.x; asm volatile("" : "+v"(tid));
    const int lane = tid & 63, wave = F.wave, col = lane & 15, q = lane >> 4, c0 = wave * 16;
    LAS unsigned char* L = F.lds;
    constexpr int WL = 0, QL = 17408, KL = 34816, GL = 53248, BUFB = 62464;
    f32x4 S[8];
#pragma unroll
    for (int i = 0; i < 8; ++i) S[i] = (f32x4){0.f, 0.f, 0.f, 0.f};
    const bf16* PZ = (const bf16*)(F.ws + WS_PZ); bf16* Y = (bf16*)(F.ws + WS_R1);
    const int otok = tid >> 3, oseg = tid & 7;
    unsigned soff[8];
#pragma unroll
    for (int j = 0; j < 8; ++j) { const int k = (wave + 8 * j) < 61 ? (wave + 8 * j) : 60; int o = 0;
        if (k < 34) { const int p = 64 * (k < 17 ? k : k - 17) + lane, row = p / 17, c = p % 17; o = row * 256 + (c < 15 ? c : 15) * 16; }
        else if (k < 61) { const int p = 64 * (k < 52 ? k - 34 : k - 52) + lane, row = p / 9, c = p % 9; o = row * 128 + (c < 7 ? c : 7) * 16; }
        soff[j] = (unsigned)o; }
    LAS float* nwl = (LAS float*)(L + 2 * BUFB);
    if (tid < HD) nwl[tid] = F.dn_norm_w[tid];
    int zero; asm volatile("v_mov_b32 %0, 0" : "=v"(zero));
    size_t gb0[8]; int gst[8], kk[8];
#pragma unroll
    for (int j = 0; j < 8; ++j) { const int k = (wave + 8 * j) < 61 ? (wave + 8 * j) : 60; kk[j] = k;
        gb0[j] = k < 17 ? WS_DNW : (k < 34 ? WS_DNQ : (k < 52 ? WS_DNK : WS_DNG)); gst[j] = k < 52 ? 16384 : 8192; }
#define SCAN_DMA(n_, buf_) do { const int cid_ = item * 32 + (n_); \
        _Pragma("unroll") for (int j = 0; j < 8; ++j) \
            __builtin_amdgcn_global_load_lds((const unsigned*)(F.ws + gb0[j] + (size_t)cid_ * gst[j] + soff[j]), (LAS unsigned*)(L + (buf_) * BUFB + kk[j] * 1024), 16, 0, 0); } while (0)
    v2u pu[4]; v4u pz[2]; float pdec;
#define SCAN_LOAD(n_) do { const int cid_ = item * 32 + (n_); \
        const bf16* up_ = (const bf16*)(F.ws + WS_DNU) + ((size_t)cid_ * 128 + c0 + col) * 64 + 4 * q; \
        _Pragma("unroll") for (int mt = 0; mt < 4; ++mt) pu[mt] = *(const GAS v2u*)(up_ + 16 * mt); \
        const bf16* zp_ = PZ + (size_t)(b * SEQ + (n_) * CHK + otok) * 512 + h * HD + 16 * oseg; \
        pz[0] = *(const GAS v4u*)zp_; pz[1] = *(const GAS v4u*)(zp_ + 8); \
        pdec = ((const float*)(F.ws + WS_DEC))[cid_ + zero]; } while (0)
    LAS unsigned char* STB = L + 2 * BUFB + 512;
    asm volatile("s_waitcnt lgkmcnt(0)" ::: "memory");
    SCAN_DMA(0, 0); SCAN_LOAD(0);
    v4u zprev[2] = {(v4u){0u, 0u, 0u, 0u}, (v4u){0u, 0u, 0u, 0u}};
#pragma unroll 1
    for (int n = 0; n <= NCHUNK; ++n) {
        const int bsel = n & 1;
        const LAS unsigned char* LB = L + bsel * BUFB;
        asm volatile("s_waitcnt vmcnt(0)" ::: "memory"); __builtin_amdgcn_s_barrier(); asm volatile("" ::: "memory");
        v2u cu[4]; v4u cz[2]; float dec = pdec; asm volatile("" : "+v"(dec));
#pragma unroll
        for (int mt = 0; mt < 4; ++mt) { cu[mt] = pu[mt]; asm volatile("" : "+v"(cu[mt])); }
        cz[0] = pz[0]; cz[1] = pz[1]; asm volatile("" : "+v"(cz[0]), "+v"(cz[1]));
        if (n + 1 < NCHUNK) { if (!(F.flags & 1)) SCAN_DMA(n + 1, bsel ^ 1); SCAN_LOAD(n + 1); }
        if (n > 0 && !(F.flags & 4)) {
            float ov_[16]; float ss = 0.f;
            { float t8[8]; unpack8(*(const LAS v4u*)(STB + otok * 272 + 32 * oseg), t8);
#pragma unroll
              for (int e = 0; e < 8; ++e) { ov_[e] = t8[e]; ss += t8[e] * t8[e]; }
              unpack8(*(const LAS v4u*)(STB + otok * 272 + 32 * oseg + 16), t8);
#pragma unroll
              for (int e = 0; e < 8; ++e) { ov_[8 + e] = t8[e]; ss += t8[e] * t8[e]; } }
            ss = sum8(ss);
            const float rstd = 1.0f / sqrtf(ss * (1.0f / HD) + RMS_EPS);
            float zf[16]; { float t8[8]; unpack8(zprev[0], t8);
#pragma unroll
              for (int e = 0; e < 8; ++e) zf[e] = t8[e];
              unpack8(zprev[1], t8);
#pragma unroll
              for (int e = 0; e < 8; ++e) zf[8 + e] = t8[e]; }
            unsigned w8[8];
            float nwv[16];
#pragma unroll
            for (int e = 0; e < 4; ++e) { const f32x4 t = *(const LAS f32x4*)(nwl + 16 * oseg + 4 * e); nwv[4 * e] = t.x; nwv[4 * e + 1] = t.y; nwv[4 * e + 2] = t.z; nwv[4 * e + 3] = t.w; }
#pragma unroll
            for (int e = 0; e < 8; ++e) w8[e] = pk2(ov_[2 * e] * rstd * nwv[2 * e] * siluf(zf[2 * e]), ov_[2 * e + 1] * rstd * nwv[2 * e + 1] * siluf(zf[2 * e + 1]));
            bf16* yp = Y + (size_t)(b * SEQ + (n - 1) * CHK + otok) * D + DD + h * HD + 16 * oseg;
            *(GAS v4u*)yp = (v4u){w8[0], w8[1], w8[2], w8[3]}; *(GAS v4u*)(yp + 8) = (v4u){w8[4], w8[5], w8[6], w8[7]};
        }
        zprev[0] = cz[0]; zprev[1] = cz[1];
        if (n == NCHUNK) break;
        bf16x8 Sb[4];
#pragma unroll
        for (int s = 0; s < 4; ++s) Sb[s] = pack8(S[2 * s], S[2 * s + 1]);
        f32x4 o[4];
#pragma unroll
        for (int mt = 0; mt < 4; ++mt) o[mt] = (f32x4){0.f, 0.f, 0.f, 0.f};
        if (!(F.flags & 2)) {
        const f32x4 z4 = (f32x4){0.f, 0.f, 0.f, 0.f};
        bf16x8 fr[16];
        f32x4 dl[4];
#pragma unroll
        for (int mt = 0; mt < 4; ++mt)
#pragma unroll
            for (int s = 0; s < 4; ++s) fr[mt * 4 + s] = ldfrag(LB + WL, 272, 16 * mt + col, s, q);
        __builtin_amdgcn_sched_barrier(0);
#pragma unroll
        for (int mt = 0; mt < 4; ++mt) dl[mt] = z4;
#pragma unroll
        for (int s = 0; s < 4; ++s)
#pragma unroll
            for (int mt = 0; mt < 4; ++mt) dl[mt] = __builtin_amdgcn_mfma_f32_16x16x32_bf16(fr[mt * 4 + s], Sb[s], dl[mt], 0, 0, 0);
#pragma unroll
        for (int mt = 0; mt < 4; ++mt)
#pragma unroll
            for (int s = 0; s < 4; ++s) fr[mt * 4 + s] = ldfrag(LB + QL, 272, 16 * mt + col, s, q);
        __builtin_amdgcn_sched_barrier(0);
#pragma unroll
        for (int mt = 0; mt < 4; ++mt) dl[mt] = (f32x4){bflo(cu[mt].x), bfhi(cu[mt].x), bflo(cu[mt].y), bfhi(cu[mt].y)} - dl[mt];
        bf16x8 Db[2];
#pragma unroll
        for (int s2 = 0; s2 < 2; ++s2) Db[s2] = pack8(dl[2 * s2], dl[2 * s2 + 1]);
#pragma unroll
        for (int s = 0; s < 4; ++s)
#pragma unroll
            for (int mt = 0; mt < 4; ++mt) o[mt] = __builtin_amdgcn_mfma_f32_16x16x32_bf16(fr[mt * 4 + s], Sb[s], o[mt], 0, 0, 0);
        fr[0] = ldfrag(LB + GL, 144, col, 0, q); fr[1] = ldfrag(LB + GL, 144, 16 + col, 0, q); fr[2] = ldfrag(LB + GL, 144, 32 + col, 0, q);
        fr[3] = ldfrag(LB + GL, 144, 32 + col, 1, q); fr[4] = ldfrag(LB + GL, 144, 48 + col, 0, q); fr[5] = ldfrag(LB + GL, 144, 48 + col, 1, q);
        __builtin_amdgcn_sched_barrier(0);
        o[0] = __builtin_amdgcn_mfma_f32_16x16x32_bf16(fr[0], Db[0], o[0], 0, 0, 0); o[1] = __builtin_amdgcn_mfma_f32_16x16x32_bf16(fr[1], Db[0], o[1], 0, 0, 0);
        o[2] = __builtin_amdgcn_mfma_f32_16x16x32_bf16(fr[2], Db[0], o[2], 0, 0, 0); o[3] = __builtin_amdgcn_mfma_f32_16x16x32_bf16(fr[4], Db[0], o[3], 0, 0, 0);
        o[2] = __builtin_amdgcn_mfma_f32_16x16x32_bf16(fr[3], Db[1], o[2], 0, 0, 0); o[3] = __builtin_amdgcn_mfma_f32_16x16x32_bf16(fr[5], Db[1], o[3], 0, 0, 0);
#pragma unroll
        for (int m8 = 0; m8 < 8; ++m8)
#pragma unroll
            for (int s2 = 0; s2 < 2; ++s2) fr[m8 * 2 + s2] = ldfrag(LB + KL, 144, 16 * m8 + col, s2, q);
        __builtin_amdgcn_sched_barrier(0);
#pragma unroll
        for (int m8 = 0; m8 < 8; ++m8) S[m8] = S[m8] * dec;
#pragma unroll
        for (int s2 = 0; s2 < 2; ++s2)
#pragma unroll
            for (int m8 = 0; m8 < 8; ++m8) S[m8] = __builtin_amdgcn_mfma_f32_16x16x32_bf16(fr[m8 * 2 + s2], Db[s2], S[m8], 0, 0, 0);
        }
        asm volatile("s_waitcnt lgkmcnt(0)" ::: "memory"); __builtin_amdgcn_s_barrier(); asm volatile("" ::: "memory");
#pragma unroll
        for (int mt = 0; mt < 4; ++mt)
#pragma unroll
            for (int r = 0; r < 4; ++r) *(LAS bf16*)(STB + (16 * mt + 4 * q + r) * 272 + (c0 + col) * 2) = (bf16)f2bf(o[mt][r]);
        asm volatile("s_waitcnt lgkmcnt(0)" ::: "memory");
    }
#undef SCAN_LOAD
#undef SCAN_DMA
}

__device__ __forceinline__ void p5_ln1_router(Frame& F) {
#if LEVEL >= 4
    LAS float* wg = (LAS float*)(F.lds);
    LAS float* we = (LAS float*)(F.lds + 16384);
#pragma unroll
    for (int it = 0; it < 2; ++it) { const int k = F.tid + NTHR * it, j = k >> 8, l = (k >> 2) & 63, e = k & 3; *(LAS f32x4*)(wg + ((j * 4 + e) * 64 + l) * 4) = *(const f32x4*)(F.w_grp + 4 * k); }
    { f32x4 t[16];
#pragma unroll
      for (int it = 0; it < 16; ++it) t[it] = *(const f32x4*)(F.w_exp + 4 * (F.tid + NTHR * it));
#pragma unroll
      for (int it = 0; it < 16; ++it) { const int i4 = F.tid + NTHR * it, k = i4 >> 3, c4 = i4 & 7, j = k >> 8, l = (k >> 2) & 63, e = k & 3; *(LAS f32x4*)(we + ((c4 * 16 + (j * 4 + e)) * 64 + l) * 4) = t[it]; } }
    __syncthreads();
#endif
    LAS int* rlist = (LAS int*)(F.lds + LDSCTL_OFF + 2048); LAS int* rhist = rlist + 256; LAS int* rbase = rhist + 32;
    const float* MOD = (const float*)(F.ws + WS_MOD);
    const bf16* MIX = (const bf16*)(F.ws + WS_MIX); float* X1 = (float*)(F.ws + WS_X1); bf16* H2 = (bf16*)(F.ws + WS_R1);
    for (int bi = F.vcu; bi < T / 128; bi += F.G) {
    const int gw = bi * NWAVES + F.wave;
    const int m0 = gw * 16, b = m0 >> 11;
    f32x4 g1[4], sc2[4], sh2[4], lg[4], lb[4];
#pragma unroll
    for (int j = 0; j < 4; ++j) { const int co = 256 * j + 4 * F.lane;
        g1[j] = *(const f32x4*)(MOD + b * 6144 + 2 * D + co); sh2[j] = *(const f32x4*)(MOD + b * 6144 + 3 * D + co); sc2[j] = *(const f32x4*)(MOD + b * 6144 + 4 * D + co);
        lg[j] = *(const f32x4*)(F.ln1_g + co); lb[j] = *(const f32x4*)(F.ln1_b + co); }
    for (int r = 0; r < 16; ++r) {
        const int m = m0 + r;
        const GAS f32x4* xr = (const GAS f32x4*)(F.x + (size_t)m * D) + F.lane;
        const GAS v2u* mr = (const GAS v2u*)(MIX + (size_t)m * D) + F.lane;
        f32x4 v[4]; float s = 0.f;
#pragma unroll
        for (int j = 0; j < 4; ++j) { const f32x4 xv = xr[64 * j];
#if LEVEL >= 2
            const v2u mw = mr[64 * j]; const f32x4 mv = (f32x4){bflo(mw.x), bfhi(mw.x), bflo(mw.y), bfhi(mw.y)};
            v[j] = xv * ALPHA + g1[j] * mv;
#else
            (void)mr; v[j] = xv * ALPHA;
#endif
            s += (v[j].x + v[j].y) + (v[j].z + v[j].w); }
        const float mean = wave_sum(s) * (1.f / D); float s2 = 0.f;
#pragma unroll
        for (int j = 0; j < 4; ++j) { v[j] = v[j] - mean; s2 += (v[j].x * v[j].x + v[j].y * v[j].y) + (v[j].z * v[j].z + v[j].w * v[j].w); }
        const float rstd = 1.f / sqrtf(wave_sum(s2) * (1.f / D) + LN_EPS);
        GAS f32x4* x1r = (GAS f32x4*)(X1 + (size_t)m * D) + F.lane;
        GAS unsigned long long* o8 = (GAS unsigned long long*)(H2 + (size_t)m * D) + F.lane;
        f32x4 h[4];
#pragma unroll
        for (int j = 0; j < 4; ++j) { const f32x4 x1 = v[j] * rstd * lg[j] + lb[j]; x1r[64 * j] = x1; h[j] = x1 * (sc2[j] + 1.0f) + sh2[j];
            o8[64 * j] = (unsigned long long)pk2(h[j].x, h[j].y) | ((unsigned long long)pk2(h[j].z, h[j].w) << 32); }
#if LEVEL >= 4
        float a[4] = {0.f, 0.f, 0.f, 0.f};
#pragma unroll
        for (int j = 0; j < 4; ++j)
#pragma unroll
            for (int e = 0; e < 4; ++e) { const float hv = h[j][e]; const f32x4 w = *(const LAS f32x4*)(wg + ((j * 4 + e) * 64 + F.lane) * 4); a[0] += hv * w.x; a[1] += hv * w.y; a[2] += hv * w.z; a[3] += hv * w.w; }
        int g = 0; float gmax = -3.0e38f, gl[4];
#pragma unroll
        for (int q = 0; q < 4; ++q) { gl[q] = wave_sum(a[q]) + F.b_grp[q]; if (gl[q] > gmax) { gmax = gl[q]; g = q; } }
        g = __builtin_amdgcn_readfirstlane(g);
        float gs = 0.f;
#pragma unroll
        for (int q = 0; q < 4; ++q) gs += __expf(gl[q] - gmax);
        const float grp_w = 1.0f / gs;
        float ea[8];
#pragma unroll
        for (int q = 0; q < 8; ++q) ea[q] = 0.f;
        const LAS float* weg = we + (size_t)g * (2 * 16 * 64 * 4);
#pragma unroll
        for (int j = 0; j < 4; ++j)
#pragma unroll
            for (int e = 0; e < 4; ++e) { const float hv = h[j][e];
                const f32x4 w0 = *(const LAS f32x4*)(weg + ((0 * 16 + (j * 4 + e)) * 64 + F.lane) * 4), w1 = *(const LAS f32x4*)(weg + ((1 * 16 + (j * 4 + e)) * 64 + F.lane) * 4);
                ea[0] += hv * w0.x; ea[1] += hv * w0.y; ea[2] += hv * w0.z; ea[3] += hv * w0.w; ea[4] += hv * w1.x; ea[5] += hv * w1.y; ea[6] += hv * w1.z; ea[7] += hv * w1.w; }
        float el[8]; int i1 = 0; float m1 = -3.0e38f;
#pragma unroll
        for (int q = 0; q < 8; ++q) { el[q] = wave_sum(ea[q]) + F.b_exp[g * 8 + q]; if (el[q] > m1) { m1 = el[q]; i1 = q; } }
        int i2 = 0; float m2 = -3.0e38f;
#pragma unroll
        for (int q = 0; q < 8; ++q) if (q != i1 && el[q] > m2) { m2 = el[q]; i2 = q; }
        const float e2 = __expf(m2 - m1), inv = 1.0f / (1.0f + e2);
        if (F.lane < 2) {
            const int e = g * 8 + (F.lane == 0 ? i1 : i2); const float gate = grp_w * (F.lane == 0 ? inv : e2 * inv);
            ((int*)(F.ws + WS_TOKE))[m * 2 + F.lane] = e; ((float*)(F.ws + WS_TOKG))[m * 2 + F.lane] = gate;
            rlist[(F.wave * 16 + r) * 2 + F.lane] = e;
        }
#endif
    }
#if LEVEL >= 4
    if (F.tid < NE) rhist[F.tid] = 0;
    __syncthreads();
    int my_e = 0, my_l = 0;
    if (F.tid < 256) { my_e = rlist[F.tid]; my_l = (int)__hip_atomic_fetch_add((LAS unsigned*)rhist + my_e, 1u, __ATOMIC_RELAXED, __HIP_MEMORY_SCOPE_WORKGROUP); }
    __syncthreads();
    if (F.tid < NE) { const unsigned c = (unsigned)rhist[F.tid]; rbase[F.tid] = c ? (int)__hip_atomic_fetch_add((unsigned*)(F.ws + WS_CTL) + CW_CNT + 64 * F.tid, c, RLX_AGENT) : 0; }
    __syncthreads();
    if (F.tid < 256) { const int rk = rbase[my_e] + my_l, mm = bi * 128 + (F.tid >> 1);
        ((int*)(F.ws + WS_ELIST))[(size_t)my_e * 65536 + rk] = mm; ((int*)(F.ws + WS_TOKR))[mm * 2 + (F.tid & 1)] = rk; }
    __syncthreads();
#endif
    }
}

constexpr int TS_OFF = LDSCTL_OFF, EC_OFF = LDSCTL_OFF + 256;
__device__ __forceinline__ void moe_tables(Frame& F) {
    LAS int* tstart = (LAS int*)(F.lds + TS_OFF); LAS int* ecnt = (LAS int*)(F.lds + EC_OFF);
    if (F.tid < NE) { unsigned* cnt = (unsigned*)(F.ws + WS_CTL) + CW_CNT;
        const int c = (int)__hip_atomic_load(cnt + 64 * F.tid, RLX_AGENT); ecnt[F.tid] = c;
        LDS_WAIT();
        int acc = 0;
        for (int k = 0; k < NE; ++k) { const int t = (ecnt[k] + 255) >> 8; acc += (k < F.tid) ? t : 0; }
        tstart[F.tid] = acc; if (F.tid == NE - 1) tstart[NE] = acc + ((c + 255) >> 8); }
    __syncthreads();
}
__device__ __forceinline__ int moe_find(const LAS int* tstart, int rt) { int e = 0;
#pragma unroll 1
    for (int k = 1; k < NE; ++k) if (tstart[k] <= rt) e = k;
    return e; }
struct MoeGU {
    static constexpr bool GATHER = true;
    const char* H2; const char* WGU; const LAS int* tstart; const LAS int* xtok; int nunits, G, c;
    __device__ __forceinline__ bool next(int i, pg8::Unit& u) const {
        const int L = i * G + c; if (L >= nunits) return false;
        const int rt = L >> 1, pn = L & 1, e = moe_find(tstart, rt);
        u.a = H2; u.b = WGU + ((size_t)e * 512 + (size_t)pn * 256) * D * 2; u.i0 = rt; u.i1 = pn; u.i2 = e; return true;
    }
    __device__ __forceinline__ void a_off(const pg8::Unit&, int ui, unsigned (&vo)[2][2], const int (&R)[2], const int (&C)[2], int K_) const {
#pragma unroll
        for (int h = 0; h < 2; ++h)
#pragma unroll
            for (int i = 0; i < 2; ++i) vo[h][i] = (unsigned)(xtok[ui * 256 + h * 128 + R[i]] * K_ + C[i]) * 2u;
    }
};
struct MoeDown {
    static constexpr bool GATHER = false;
    const char* HID; const char* WD; const LAS int* tstart; int nunits, G, c;
    __device__ __forceinline__ bool next(int i, pg8::Unit& u) const {
        const int L = i * G + c; if (L >= nunits) return false;
        const int rt = L >> 2, pn = L & 3, e = moe_find(tstart, rt);
        u.a = HID + (size_t)rt * 256 * DE * 2; u.b = WD + ((size_t)e * D + (size_t)pn * 256) * DE * 2; u.i0 = rt; u.i1 = pn; u.i2 = e; return true;
    }
    __device__ __forceinline__ void a_off(const pg8::Unit&, int, unsigned (&vo)[2][2], const int (&R)[2], const int (&C)[2], int K_) const {
#pragma unroll
        for (int h = 0; h < 2; ++h)
#pragma unroll
            for (int i = 0; i < 2; ++i) vo[h][i] = (unsigned)((h * 128 + R[i]) * K_ + C[i]) * 2u;
    }
};
struct EpiGU {
    static constexpr bool PERM = true;
    bf16* HID;
    __device__ __forceinline__ void operator()(const f32x4 (&acc)[2][2][4][2], const pg8::Unit& u, int wr, int wc, int fr, int fq) const {
        const int row0 = u.i0 * 256 + wr * 64 + fr, col0 = u.i1 * 128 + wc * 32 + 8 * fq;
#pragma unroll
        for (int ai = 0; ai < 2; ++ai)
#pragma unroll
            for (int m = 0; m < 4; ++m) { bf16* rowp = HID + (size_t)(row0 + ai * 128 + m * 16) * DE + col0;
                const f32x4 g0 = acc[ai][0][m][0], g1 = acc[ai][0][m][1], u0 = acc[ai][1][m][0], u1 = acc[ai][1][m][1];
                v4u w; w.x = pg8::cvt_pk_bf16(siluf(g0[0]) * u0[0], siluf(g0[1]) * u0[1]); w.y = pg8::cvt_pk_bf16(siluf(g0[2]) * u0[2], siluf(g0[3]) * u0[3]);
                w.z = pg8::cvt_pk_bf16(siluf(g1[0]) * u1[0], siluf(g1[1]) * u1[1]); w.w = pg8::cvt_pk_bf16(siluf(g1[2]) * u1[2], siluf(g1[3]) * u1[3]);
                *(v4u*)rowp = w; }
    }
};
__device__ __forceinline__ void p7_gateup(Frame& F) {
    moe_tables(F);
    const LAS int* tstart = (const LAS int*)(F.lds + TS_OFF); const LAS int* ecnt = (const LAS int*)(F.lds + EC_OFF);
    LAS int* xtok = (LAS int*)(F.lds + XTOK_OFF);
    MoeGU S{(const char*)(F.ws + WS_R1), (const char*)(F.ws + WS_WGU), tstart, xtok, 2 * tstart[NE], F.G, F.vcu};
    pg8::Unit u;
    for (int ui = 0; ui < 8 && S.next(ui, u); ++ui) {
        if (F.tid < 256) { const int e = u.i2, idx = (u.i0 - tstart[e]) * 256 + F.tid;
            xtok[ui * 256 + F.tid] = idx < ecnt[e] ? ((const int*)(F.ws + WS_ELIST))[(size_t)e * 65536 + idx] : 0; }
    }
    __syncthreads();
    EpiGU E{(bf16*)(F.ws + WS_HID)};
    pg8::gemm_phase<EpiGU, MoeGU, true, true>(F.lds + RING_OFF, D, S, E);
}
__device__ __forceinline__ void p8_down(Frame& F) {
    moe_tables(F);
    const LAS int* tstart = (const LAS int*)(F.lds + TS_OFF);
    MoeDown S{(const char*)(F.ws + WS_HID), (const char*)(F.ws + WS_WD), tstart, 4 * tstart[NE], F.G, F.vcu};
    EpiBf E{(bf16*)(F.ws + WS_YR), D};
    int Kd = DE; asm volatile("" : "+s"(Kd));
    pg8::gemm_phase<EpiBf, MoeDown, true, true>(F.lds + RING_OFF, Kd, S, E);
}

__device__ __forceinline__ void p9_final(Frame& F) {
    const float* MOD = (const float*)(F.ws + WS_MOD);
    const float* X1 = (const float*)(F.ws + WS_X1);
#if LEVEL >= 4
    LAS int* pst = (LAS int*)(F.lds);
    if (F.tid < NE) { unsigned* cnt = (unsigned*)(F.ws + WS_CTL) + CW_CNT; LAS int* tmp = pst + 64;
        tmp[F.tid] = (int)((__hip_atomic_load(cnt + 64 * F.tid, RLX_AGENT) + 255u) & ~255u);
        LDS_WAIT();
        int acc = 0;
        for (int k = 0; k < NE; ++k) { const int t = tmp[k]; acc += (k < F.tid) ? t : 0; }
        pst[F.tid] = acc; }
    __syncthreads();
    const bf16* YR = (const bf16*)(F.ws + WS_YR);
#endif
    for (int gw = F.vcu * NWAVES + F.wave; gw < T / 16; gw += F.G * NWAVES) {
    const int m0 = gw * 16, b = m0 >> 11;
    f32x4 g2[4], lg[4], lb[4];
#pragma unroll
    for (int j = 0; j < 4; ++j) { const int co = 256 * j + 4 * F.lane; g2[j] = *(const f32x4*)(MOD + b * 6144 + 5 * D + co); lg[j] = *(const f32x4*)(F.ln2_g + co); lb[j] = *(const f32x4*)(F.ln2_b + co); }
    for (int r = 0; r < 16; ++r) {
        const int m = m0 + r;
        const GAS f32x4* xr = (const GAS f32x4*)(X1 + (size_t)m * D) + F.lane;
        f32x4 v[4]; float s = 0.f;
#if LEVEL >= 4
        const int l1 = F.lane & 1;
        const int ee = ((const int*)(F.ws + WS_TOKE))[m * 2 + l1], rr = ((const int*)(F.ws + WS_TOKR))[m * 2 + l1]; const float gg = ((const float*)(F.ws + WS_TOKG))[m * 2 + l1];
        const int sl = pst[ee] + rr;
        const int s0 = __shfl(sl, 0), s1 = __shfl(sl, 1); const float ga = __shfl(gg, 0), gb = __shfl(gg, 1);
        const GAS v2u* y0 = (const GAS v2u*)(YR + (size_t)s0 * D) + F.lane; const GAS v2u* y1 = (const GAS v2u*)(YR + (size_t)s1 * D) + F.lane;
#endif
#pragma unroll
        for (int j = 0; j < 4; ++j) { const f32x4 xv = xr[64 * j];
#if LEVEL >= 4
            const v2u a = y0[64 * j], c = y1[64 * j];
            const f32x4 f = (f32x4){bflo(a.x), bfhi(a.x), bflo(a.y), bfhi(a.y)} * ga + (f32x4){bflo(c.x), bfhi(c.x), bflo(c.y), bfhi(c.y)} * gb;
            v[j] = xv * ALPHA + g2[j] * f;
#else
            v[j] = xv * ALPHA;
#endif
            s += (v[j].x + v[j].y) + (v[j].z + v[j].w); }
        const float mean = wave_sum(s) * (1.f / D); float s2 = 0.f;
#pragma unroll
        for (int j = 0; j < 4; ++j) { v[j] = v[j] - mean; s2 += (v[j].x * v[j].x + v[j].y * v[j].y) + (v[j].z * v[j].z + v[j].w * v[j].w); }
        const float rstd = 1.f / sqrtf(wave_sum(s2) * (1.f / D) + LN_EPS);
        GAS f32x4* orow = (GAS f32x4*)(F.out + (size_t)m * D) + F.lane;
#pragma unroll
        for (int j = 0; j < 4; ++j) orow[64 * j] = v[j] * rstd * lg[j] + lb[j];
    }
    (void)g2;
    }
}

constexpr int NPHASE = 10;
struct Args { const float* in[23]; float* out; unsigned char* ws; int ph_lo, ph_hi, flags, pad; };
__global__ void __launch_bounds__(NTHR, 2) fwd_kernel(Args args) {
    extern __shared__ __attribute__((aligned(16))) unsigned char lds[];
    Frame F;
    F.lds = (LAS unsigned char*)lds;
    F.tid = threadIdx.x; F.lane = F.tid & 63; F.wave = __builtin_amdgcn_readfirstlane(F.tid >> 6);
    F.G = gridDim.x; { const int bx = blockIdx.x; F.vcu = (F.G % 8 == 0) ? (bx % 8) * (F.G / 8) + bx / 8 : bx; }
    F.x = args.in[0]; F.c = args.in[1]; F.w_ada = args.in[2]; F.b_ada = args.in[3]; F.w_in = args.in[4]; F.conv_w = args.in[5]; F.conv_norm_w = args.in[6];
    F.dn_conv_w = args.in[7]; F.dn_A_log = args.in[8]; F.dn_dt_bias = args.in[9]; F.dn_norm_w = args.in[10]; F.w_out = args.in[11]; F.ln1_g = args.in[12]; F.ln1_b = args.in[13];
    F.w_grp = args.in[14]; F.b_grp = args.in[15]; F.w_exp = args.in[16]; F.b_exp = args.in[17]; F.w_gate = args.in[18]; F.w_up = args.in[19]; F.w_down = args.in[20];
    F.ln2_g = args.in[21]; F.ln2_b = args.in[22]; F.out = args.out; F.ws = args.ws; F.flags = args.flags;
    volatile LAS unsigned* MISC = (volatile LAS unsigned*)(F.lds + MISC_OFF);
    for (int u = F.tid; u < (LDS_BYTES - LDSCTL_OFF) / 4; u += NTHR) ((LAS unsigned*)(F.lds + LDSCTL_OFF))[u] = 0u;
    __syncthreads();
    XcdBarrier bar; bar.bar = (unsigned*)(F.ws + WS_CTL) + CW_BAR; bar.x = 0; bar.st = nullptr;
    const int lo = args.ph_lo, hi = args.ph_hi;
    if (hi - lo > 1) bar = xcd_barrier_post((unsigned*)(F.ws + WS_CTL) + CW_BAR, MISC + 8);
#define IN(k) (lo <= (k) && (k) < hi)
#define SEAM(k) do { if (IN(k) && IN((k) + 1)) xcd_barrier(bar); } while (0)
    constexpr int reps[NPHASE] = REPS;
#define REPEAT(k) for (int rep_ = 0; rep_ < reps[k]; ++rep_, (rep_ < reps[k] ? xcd_barrier(bar) : (void)0))

    if (IN(0)) REPEAT(0) { p0_prologue(F); } SEAM(0);
    if (IN(1)) REPEAT(1) { p1_modulate(F); } SEAM(1);
    if (IN(2)) REPEAT(2) {
#if LEVEL >= 2
        pg8::DenseOrder S; S.init(F.ws + WS_R1, F.ws + WS_WIN, T, NMAIN, D, F.G, (int)blockIdx.x);
        EpiP E{F.ws};
        pg8::gemm_phase<EpiP, pg8::DenseOrder, true, true>(F.lds + RING_OFF, D, S, E);
#endif
    } SEAM(2);
    if (IN(3)) REPEAT(3) {
#if LEVEL == 2
        p3a_convmix(F, F.vcu * NWAVES + F.wave, F.G * NWAVES);
#endif
#if LEVEL == 2
        zero_ydelta(F);
#endif
#if LEVEL >= 3 && !defined(NO_PRE)
        dn_pre(F);
#endif
#ifdef EXP_DELAY
        { const unsigned long long t0 = __builtin_amdgcn_s_memrealtime(); while (__builtin_amdgcn_s_memrealtime() - t0 < 60000ull) __builtin_amdgcn_s_sleep(16); }
#endif
    } SEAM(3);
    if (IN(4)) REPEAT(4) {
#if LEVEL >= 3 && !defined(NO_SCAN)
        if ((int)blockIdx.x < NB * NH) dn_scan(F);
        else if (F.G > NB * NH) p3a_convmix(F, ((int)blockIdx.x - NB * NH) * NWAVES + F.wave, (F.G - NB * NH) * NWAVES);
#endif
    } SEAM(4);
    if (IN(5)) REPEAT(5) {
#if LEVEL >= 2
        pg8::DenseOrder S; S.init(F.ws + WS_R1, F.ws + WS_WOUT, T, D, D, F.G, (int)blockIdx.x);
        EpiBf E{(bf16*)(F.ws + WS_MIX), D};
        pg8::gemm_phase<EpiBf, pg8::DenseOrder, true, true>(F.lds + RING_OFF, D, S, E);
#endif
    } SEAM(5);
    if (IN(6)) REPEAT(6) { p5_ln1_router(F); } SEAM(6);
    if (IN(7)) REPEAT(7) {
#if LEVEL >= 4
        p7_gateup(F);
#endif
    } SEAM(7);
    if (IN(8)) REPEAT(8) {
#if LEVEL >= 4
        p8_down(F);
#endif
    } SEAM(8);
    if (IN(9)) REPEAT(9) { p9_final(F); }
    if (IN(10)) { p3a_convmix(F, F.vcu * NWAVES + F.wave, F.G * NWAVES); }
    if (IN(11)) { if ((int)blockIdx.x < NB * NH) dn_scan(F); }
    if (IN(12)) { if ((int)blockIdx.x >= NB * NH) p3a_convmix(F, ((int)blockIdx.x - NB * NH) * NWAVES + F.wave, (F.G - NB * NH) * NWAVES); }
#undef IN
#undef SEAM
}

extern "C" void kernel_launch(void* const* d_in, const int* in_sizes, int n_in, void* d_out, int out_size, void* d_ws, size_t ws_size, hipStream_t stream) {
    static int grid = 0;
    if (grid == 0) {
        if (n_in != 23 || in_sizes[0] != T * D || out_size != T * D || ws_size < WS_END) { fprintf(stderr, "kernel_launch: unexpected shapes (n_in %d, in0 %d, out %d, ws %zu)\n", n_in, n_in > 0 ? in_sizes[0] : -1, out_size, ws_size); grid = -1; return; }
        int dev = 0, cus = 0, per_cu = 0;
        if (hipGetDevice(&dev) != hipSuccess || hipDeviceGetAttribute(&cus, hipDeviceAttributeMultiprocessorCount, dev) != hipSuccess) { grid = -1; return; }
        if (hipFuncSetAttribute((const void*)fwd_kernel, hipFuncAttributeMaxDynamicSharedMemorySize, LDS_BYTES) != hipSuccess) { fprintf(stderr, "kernel_launch: hipFuncSetAttribute failed\n"); grid = -1; return; }
        if (hipOccupancyMaxActiveBlocksPerMultiprocessor(&per_cu, (const void*)fwd_kernel, NTHR, LDS_BYTES) != hipSuccess || per_cu < 1) fprintf(stderr, "kernel_launch: occupancy query says %d\n", per_cu);
        (void)hipGetLastError();
        grid = cus;
        if (grid != 256) fprintf(stderr, "kernel_launch: %d CUs (built for 256)\n", grid);
    }
    if (grid < 0) return;
    if (hipMemsetAsync((char*)d_ws + WS_CTL, 0, CTL_ZERO_BYTES, stream) != hipSuccess) return;
    Args a{};
    for (int i = 0; i < 23; ++i) a.in[i] = (const float*)d_in[i];
    a.out = (float*)d_out; a.ws = (unsigned char*)d_ws;
#if MK_ONE_LAUNCH
    a.ph_lo = 0; a.ph_hi = NPHASE;
    hipLaunchKernelGGL(fwd_kernel, dim3(grid), dim3(NTHR), LDS_BYTES, stream, a);
#ifdef PROBE_PHASE
    a.flags = PROBE_FLAGS;
    for (int r = 0; r < PROBE_REP; ++r) { a.ph_lo = PROBE_PHASE; a.ph_hi = PROBE_PHASE + 1; hipLaunchKernelGGL(fwd_kernel, dim3(grid), dim3(NTHR), LDS_BYTES, stream, a); }
#endif
#else
    for (int p = 0; p < NPHASE; ++p) { a.ph_lo = p; a.ph_hi = p + 1; hipLaunchKernelGGL(fwd_kernel, dim3(grid), dim3(NTHR), LDS_BYTES, stream, a); }
#endif
}
```

```cpp
#include <hip/hip_runtime.h>
#include <cstdio>
#include <cstdint>
#include <utility>

#ifndef PROBE_FLAGS
#define PROBE_FLAGS 0
#endif
#ifndef LEVEL
#define LEVEL 4
#endif
#ifndef MK_ONE_LAUNCH
#define MK_ONE_LAUNCH 1
#endif

#ifndef REPS
#define REPS {1,1,1,1,1,1,1,1,1,1}
#endif
#define GAS __attribute__((address_space(1)))
#define LAS __attribute__((address_space(3)))
typedef unsigned short bf16;
typedef unsigned v4u __attribute__((ext_vector_type(4)));
typedef unsigned v2u __attribute__((ext_vector_type(2)));
typedef float f32x4 __attribute__((ext_vector_type(4)));
typedef float f32x2 __attribute__((ext_vector_type(2)));
typedef short bf16x8 __attribute__((ext_vector_type(8)));
typedef GAS unsigned gu32;
#define RLX_AGENT __ATOMIC_RELAXED, __HIP_MEMORY_SCOPE_AGENT
#define LDS_WAIT() asm volatile("s_waitcnt lgkmcnt(0)" ::: "memory")
#define VM_WAIT() asm volatile("s_waitcnt vmcnt(0)" ::: "memory")

constexpr int NWAVES = 8, NTHR = 512;
constexpr int NB = 16, SEQ = 2048, D = 1024, T = NB * SEQ;
constexpr int DIN = 3592, NMAIN = 3584;
constexpr int DC = 512, CONVG = 64;
constexpr int NH = 4, HD = 128, DD = 512;
constexpr int CHK = 64, NCHUNK = SEQ / CHK, NCHUNK_ALL = NB * NH * NCHUNK;
constexpr int NE = 32, EPG = 8, NG = 4, DE = 256;
constexpr float LN_EPS = 1e-5f, RMS_EPS = 1e-6f;
constexpr float ALPHA = 1.18920711500272f;
constexpr int MAXROWS = T * 2 + NE * 256;

constexpr size_t MiB = 1u << 20;
constexpr size_t WS_CTL = 0, CTL_ZERO_BYTES = 1 * MiB;
constexpr size_t WS_MOD = 1 * MiB;
constexpr size_t WS_BA = 1 * MiB + 512 * 1024;
constexpr size_t WS_TOKE = 3 * MiB, WS_TOKR = 3 * MiB + 256 * 1024, WS_TOKG = 3 * MiB + 512 * 1024, WS_DEC = 3 * MiB + 768 * 1024;
constexpr size_t WS_ELIST = 4 * MiB;
constexpr size_t WS_WIN = 12 * MiB, WS_WOUT = 19 * MiB, WS_WGU = 21 * MiB, WS_WD = 53 * MiB;
constexpr size_t WS_R1 = 72 * MiB;
constexpr size_t WS_PBCU = 136 * MiB, WS_PQKV = 232 * MiB, WS_PZ = 328 * MiB;
constexpr size_t WS_DNW = 360 * MiB, WS_DNQ = 392 * MiB, WS_DNK = 424 * MiB, WS_DNG = 456 * MiB, WS_DNU = 472 * MiB;
constexpr size_t WS_MIX = 136 * MiB, WS_X1 = 232 * MiB, WS_HID = 136 * MiB, WS_YR = 360 * MiB;
constexpr size_t WS_END = 504 * MiB;
constexpr int CW_CNT = 64;
constexpr int CW_BAR = 4096;

constexpr int RING_OFF = 0, RING_BYTES = 131072;
constexpr int XTOK_OFF = 131072;
constexpr int LDSCTL_OFF = 147456, MISC_OFF = LDSCTL_OFF + 1024;
constexpr int LDS_BYTES = 155648;

typedef __bf16 bf16n2 __attribute__((ext_vector_type(2)));
__device__ __forceinline__ unsigned pk2(float lo, float hi) { const bf16n2 b = __builtin_convertvector((f32x2){lo, hi}, bf16n2); return __builtin_bit_cast(unsigned, b); }
__device__ __forceinline__ unsigned f2bf(float f) { return pk2(f, 0.f) & 0xffffu; }
__device__ __forceinline__ float bflo(unsigned w) { return __builtin_bit_cast(float, w << 16); }
__device__ __forceinline__ float bfhi(unsigned w) { return __builtin_bit_cast(float, w & 0xffff0000u); }
__device__ __forceinline__ float bf1(bf16 b) { return __builtin_bit_cast(float, ((unsigned)b) << 16); }
template <int CTRL, int ROWMASK>
__device__ __forceinline__ float dppf(float v) { return __builtin_bit_cast(float, __builtin_amdgcn_update_dpp(0, __builtin_bit_cast(int, v), CTRL, ROWMASK, 0xf, false)); }
__device__ __forceinline__ float sum4(float v) { v += dppf<0xB1, 0xf>(v); v += dppf<0x4E, 0xf>(v); return v; }
__device__ __forceinline__ float sum8(float v) { v = sum4(v); v += dppf<0x141, 0xf>(v); return v; }
__device__ __forceinline__ float sum16(float v) { v = sum8(v); v += dppf<0x140, 0xf>(v); return v; }
__device__ __forceinline__ float wave_sum(float v) {
    v = sum16(v); v += dppf<0x142, 0xa>(v); v += dppf<0x143, 0xc>(v);
    return __builtin_bit_cast(float, __builtin_amdgcn_readlane(__builtin_bit_cast(int, v), 63));
}
__device__ __forceinline__ float siluf(float x) { return x * __builtin_amdgcn_rcpf(1.f + __expf(-x)); }

namespace pg8 {
#define PG8_LAS __attribute__((address_space(3)))
typedef unsigned short bf16_t;
typedef unsigned u32x4 __attribute__((ext_vector_type(4)));
constexpr int BM = 256, BK = 64, HALF = 128, HTB = HALF * BK * 2, STAGE_BYTES = 8 * HTB;

__host__ __device__ __forceinline__ int lds_byte(int r, int c) { const int st = (r >> 4) * 2 + (c >> 5), rr = r & 15, cc = c & 31, ob = rr * 64 + cc * 2; return st * 1024 + (ob ^ (((ob >> 9) & 1) << 5)); }
__host__ __device__ __forceinline__ void stage_rc(int b, int& R, int& C) { const int st = b / 1024, sb = b % 1024, swz = sb ^ (((sb >> 9) & 1) << 5); R = (st >> 1) * 16 + swz / 64; C = (st & 1) * 32 + (swz % 64) / 2; }
__host__ __device__ __forceinline__ int perm32(int rho) { const int n = rho >> 4, i = rho & 15; return 8 * (i >> 2) + 4 * n + (i & 3); }

struct Unit { const char* a; const char* b; int i0, i1, i2; };

__device__ __forceinline__ unsigned cvt_pk_bf16(float lo, float hi) { return pk2(lo, hi); }

template <class Epi, class Sched, bool ALIGN_EPI = false, bool SP2 = true>
__device__ __forceinline__ void gemm_phase(PG8_LAS unsigned char* lds, const int K, const Sched& S, const Epi& E) {
    const int tid = threadIdx.x, wid = __builtin_amdgcn_readfirstlane(tid >> 6), lane = tid & 63, wr = wid >> 2, wc = wid & 3, fr = lane & 15, fq = lane >> 4;
    const int nt = K / BK;
    int R[2], C[2];
    unsigned voffA[2][2], nvoffA[2][2], voffB[2];
#pragma unroll
    for (int i = 0; i < 2; ++i) { stage_rc(tid * 16 + i * 8192, R[i], C[i]); const int Rb = Epi::PERM ? ((R[i] & ~31) + perm32(R[i] & 31)) : R[i];
        voffB[i] = (unsigned)(Rb * K + C[i]) * 2u; }
    const size_t kstep = (size_t)(BK * 2);
    const size_t hstep = (size_t)HALF * K * 2;
    const unsigned ldsw = (unsigned)wid * 1024u;
    const int aoff = lds_byte(wr * 64 + fr, fq * 8), boff = lds_byte(wc * 32 + fr, fq * 8);
#define PG8_SA(b, h) (((b) * 2 + (h)) * HTB)
#define PG8_SB(b, h) ((4 + (b) * 2 + (h)) * HTB)
#define PG8_STAGEB(bufoff, gbase) do { _Pragma("unroll") for (int _i = 0; _i < 2; ++_i) \
        __builtin_amdgcn_global_load_lds((const unsigned*)((const char*)(gbase) + voffB[_i]), (PG8_LAS unsigned*)(lds + (bufoff) + ldsw + _i * 8192), 16, 0, 0); } while (0)
#define PG8_STAGEA(bufoff, gbase, vo, h) do { _Pragma("unroll") for (int _i = 0; _i < 2; ++_i) \
        __builtin_amdgcn_global_load_lds((const unsigned*)((const char*)(gbase) + (vo)[h][_i]), (PG8_LAS unsigned*)(lds + (bufoff) + ldsw + _i * 8192), 16, 0, 0); } while (0)
#define PG8_LDA(dst, b, h) do { _Pragma("unroll") for (int m = 0; m < 4; ++m) _Pragma("unroll") for (int k = 0; k < 2; ++k) dst[m][k] = *(const PG8_LAS bf16x8*)(lds + PG8_SA(b, h) + aoff + m * 2048 + k * 1024); } while (0)
#define PG8_LDB(dst, b, h) do { _Pragma("unroll") for (int n = 0; n < 2; ++n) _Pragma("unroll") for (int k = 0; k < 2; ++k) dst[n][k] = *(const PG8_LAS bf16x8*)(lds + PG8_SB(b, h) + boff + n * 2048 + k * 1024); } while (0)
#define PG8_MMA(ai, bj, At, Bt) do { __builtin_amdgcn_s_setprio(1); _Pragma("unroll") for (int m = 0; m < 4; ++m) _Pragma("unroll") for (int n = 0; n < 2; ++n) _Pragma("unroll") for (int k = 0; k < 2; ++k) \
        acc[ai][bj][m][n] = __builtin_amdgcn_mfma_f32_16x16x32_bf16(Bt[n][k], At[m][k], acc[ai][bj][m][n], 0, 0, 0); __builtin_amdgcn_s_setprio(0); } while (0)
#define PG8_WAIT_V(n) asm volatile("s_waitcnt vmcnt(" #n ")" ::: "memory")
#define PG8_WAIT_L(n) asm volatile("s_waitcnt lgkmcnt(" #n ")" ::: "memory")
#define PG8_BAR __builtin_amdgcn_s_barrier()
#define PG8_SCHED __builtin_amdgcn_sched_barrier(0)
    Unit cur, nxt; int ui = 0;
    if (!S.next(0, cur)) return;
    S.a_off(cur, 0, voffA, R, C, K);
    f32x4 acc[2][2][4][2];
#pragma unroll
    for (int a = 0; a < 2; ++a)
#pragma unroll
        for (int b = 0; b < 2; ++b)
#pragma unroll
            for (int m = 0; m < 4; ++m)
#pragma unroll
                for (int n = 0; n < 2; ++n) acc[a][b][m][n] = (f32x4){0.f, 0.f, 0.f, 0.f};
    bf16x8 At[4][2], B0[2][2], B1[2][2];
    const char* cA = cur.a; const char* cB = cur.b;
    static_assert(SP2, "only the SP2 loop is kept in this file");
    PG8_STAGEB(PG8_SB(0, 0), cB); PG8_STAGEB(PG8_SB(0, 1), cB + hstep); PG8_STAGEA(PG8_SA(0, 0), cA, voffA, 0); PG8_STAGEA(PG8_SA(0, 1), cA, voffA, 1);
    if (wr == 1) PG8_BAR;
    PG8_WAIT_V(2); PG8_BAR;
    PG8_STAGEB(PG8_SB(1, 0), cB + kstep); PG8_STAGEA(PG8_SA(1, 0), cA + kstep, voffA, 0); PG8_STAGEB(PG8_SB(1, 1), cB + hstep + kstep);
    PG8_WAIT_V(6); PG8_BAR;
    for (;;) {
        const bool has_next = S.next(ui + 1, nxt);
        const char* nA = has_next ? nxt.a : cA; const char* nB = has_next ? nxt.b : cB;
        if (Sched::GATHER && has_next) S.a_off(nxt, ui + 1, nvoffA, R, C, K);
        else {
#pragma unroll
            for (int h = 0; h < 2; ++h)
#pragma unroll
                for (int i = 0; i < 2; ++i) nvoffA[h][i] = voffA[h][i]; }
        for (int t = 0; t < nt; t += 2) {
            const bool last = (t == nt - 2);
            const char* a1 = cA + (size_t)(t + 1) * kstep;
            const char* a2 = last ? nA : cA + (size_t)(t + 2) * kstep; const char* b2 = last ? nB : cB + (size_t)(t + 2) * kstep;
            const char* a3 = a2 + kstep; const char* b3 = b2 + kstep;
            unsigned va2[2][2];
#pragma unroll
            for (int h = 0; h < 2; ++h)
#pragma unroll
                for (int i = 0; i < 2; ++i) va2[h][i] = (Sched::GATHER && last) ? nvoffA[h][i] : voffA[h][i];
            PG8_LDB(B0, 0, 0); PG8_LDB(B1, 0, 1); PG8_SCHED; PG8_LDA(At, 0, 0); PG8_STAGEA(PG8_SA(1, 1), a1, voffA, 1);
            PG8_WAIT_V(8); PG8_WAIT_L(0); PG8_BAR; PG8_MMA(0, 0, At, B0); PG8_MMA(0, 1, At, B1); PG8_BAR; PG8_SCHED;
            PG8_LDA(At, 0, 1); PG8_STAGEB(PG8_SB(0, 0), b2); PG8_STAGEB(PG8_SB(0, 1), b2 + hstep); PG8_STAGEA(PG8_SA(0, 0), a2, va2, 0);
            PG8_WAIT_V(8); PG8_WAIT_L(0); PG8_BAR; PG8_MMA(1, 0, At, B0); PG8_MMA(1, 1, At, B1); PG8_BAR; PG8_SCHED;
            PG8_LDB(B0, 1, 0); PG8_LDB(B1, 1, 1); PG8_SCHED; PG8_LDA(At, 1, 0); PG8_STAGEA(PG8_SA(0, 1), a2, va2, 1);
            PG8_WAIT_V(8); PG8_WAIT_L(0); PG8_BAR; PG8_MMA(0, 0, At, B0); PG8_MMA(0, 1, At, B1); PG8_BAR; PG8_SCHED;
            PG8_LDA(At, 1, 1); PG8_STAGEB(PG8_SB(1, 0), b3); PG8_STAGEB(PG8_SB(1, 1), b3 + hstep); PG8_STAGEA(PG8_SA(1, 0), a3, va2, 0);
            PG8_WAIT_V(8); PG8_WAIT_L(0); PG8_BAR; PG8_MMA(1, 0, At, B0); PG8_MMA(1, 1, At, B1); PG8_BAR; PG8_SCHED;
        }
        if constexpr (ALIGN_EPI) { if (wr == 0) PG8_BAR; }
        E(acc, cur, wr, wc, fr, fq);
        if (!has_next) break;
#pragma unroll
        for (int a = 0; a < 2; ++a)
#pragma unroll
            for (int b = 0; b < 2; ++b)
#pragma unroll
                for (int m = 0; m < 4; ++m)
#pragma unroll
                    for (int n = 0; n < 2; ++n) acc[a][b][m][n] = (f32x4){0.f, 0.f, 0.f, 0.f};
        cur = nxt; cA = nA; cB = nB; ++ui;
#pragma unroll
        for (int h = 0; h < 2; ++h)
#pragma unroll
            for (int i = 0; i < 2; ++i) voffA[h][i] = nvoffA[h][i];
        if constexpr (ALIGN_EPI) { if (wr == 1) PG8_BAR; }
    }
    PG8_WAIT_V(0);
    if constexpr (!ALIGN_EPI) { if (wr == 0) PG8_BAR; }
    PG8_BAR;
#undef PG8_SA
#undef PG8_SB
#undef PG8_STAGEA
#undef PG8_STAGEB
#undef PG8_LDA
#undef PG8_LDB
#undef PG8_MMA
#undef PG8_WAIT_V
#undef PG8_WAIT_L
#undef PG8_BAR
#undef PG8_SCHED
}

struct DenseOrder {
    static constexpr bool GATHER = false;
    const char* A; const char* Bt; int nM, nN, nwg, G, c, K;
    __device__ void init(const void* A_, const void* Bt_, int M, int N, int K_, int G_, int c_) { A = (const char*)A_; Bt = (const char*)Bt_; nM = M / BM; nN = N / BM; nwg = nM * nN; G = G_; c = c_; K = K_; }
    __device__ __forceinline__ bool next(int i, Unit& u) const {
        const long L = (long)i * G + c; if (L >= nwg) return false;
        int wgid = (int)L; { const int q = nwg / 8, r = nwg % 8, xcd = wgid % 8, off = wgid / 8; wgid = (xcd < r ? xcd * (q + 1) : r * (q + 1) + (xcd - r) * q) + off; }
        const int nig = 8 * nN, gid = wgid / nig, fm = gid * 8, gsz = (nM - fm) < 8 ? (nM - fm) : 8;
        const int pm = fm + ((wgid % nig) % gsz), pn = (wgid % nig) / gsz;
        u.a = A + (size_t)pm * BM * K * 2; u.b = Bt + (size_t)pn * BM * K * 2; u.i0 = pm; u.i1 = pn; u.i2 = 0; return true;
    }
    __device__ __forceinline__ void a_off(const Unit&, int, unsigned (&vo)[2][2], const int (&R)[2], const int (&C)[2], int K_) const {
#pragma unroll
        for (int h = 0; h < 2; ++h)
#pragma unroll
            for (int i = 0; i < 2; ++i) vo[h][i] = (unsigned)((h * HALF + R[i]) * K_ + C[i]) * 2u;
    }
};
}

#define XB_TMO      128
#define XB_XCNT(j)  (256  + 64 * (j))
#define XB_XSUB(j)  (1280 + 64 * (j))
#define XB_XGEN(j)  (2304 + 64 * (j))
#define XB_TOP      3328
#define XB_TOPGEN   3392
#define XCD_BAR_WORDS 3456
#define XB_SPIN_CAP (1u << 18)
__device__ __forceinline__ unsigned xb_ld(unsigned* p)              { return __hip_atomic_load(p, __ATOMIC_RELAXED, __HIP_MEMORY_SCOPE_AGENT); }
__device__ __forceinline__ unsigned xb_add(unsigned* p, unsigned v) { return __hip_atomic_fetch_add(p, v, __ATOMIC_RELAXED, __HIP_MEMORY_SCOPE_AGENT); }
__device__ __forceinline__ unsigned xb_xcc_id() { return (unsigned)__builtin_amdgcn_s_getreg((3 << 11) | 20) & 0xFu; }
#define XB_SPIN(cond, bar) do { unsigned _sp = 0; while (cond) { __builtin_amdgcn_s_sleep(1); \
    if ((++_sp & 255u) == 0u) { if (xb_ld(&(bar)[XB_TMO])) break; if (_sp > XB_SPIN_CAP) { atomicAdd(&(bar)[XB_TMO], 1u); break; } } } } while (0)
struct XcdBarrier { unsigned* bar; unsigned x; volatile LAS unsigned* st; };
__device__ __forceinline__ XcdBarrier xcd_barrier_post(unsigned* bar, volatile LAS unsigned* st) {
    XcdBarrier b; b.bar = bar; b.x = xb_xcc_id(); b.st = st;
    if (threadIdx.x == 0) (void)xb_add(&bar[XB_XCNT(b.x)], 1u);
    return b;
}
__device__ __forceinline__ void xcd_barrier_complete(unsigned* bar, unsigned x, unsigned& nloc, unsigned& nx) {
    const unsigned G = gridDim.x * gridDim.y * gridDim.z;
    unsigned sum, cnt, mine, sp = 0u;
    for (;;) {
        sum = 0u; cnt = 0u; mine = 0u;
#pragma unroll
        for (unsigned j = 0; j < 16; ++j) { const unsigned c = xb_ld(&bar[XB_XCNT(j)]); sum += c; cnt += (c > 0u) ? 1u : 0u; mine = (j == x) ? c : mine; }
        if (sum == G) break;
        __builtin_amdgcn_s_sleep(1);
        if ((++sp & 255u) == 0u) { if (xb_ld(&bar[XB_TMO])) break; if (sp > XB_SPIN_CAP) { atomicAdd(&bar[XB_TMO], 1u); break; } }
    }
    nloc = mine > 0u ? mine : 1u; nx = cnt > 0u ? cnt : 1u;
}
__device__ __forceinline__ void xcd_barrier(const XcdBarrier& b) {
    asm volatile("s_waitcnt vmcnt(0)" ::: "memory");
    __syncthreads();
    if (threadIdx.x == 0) {
        unsigned* bar = b.bar;
        __builtin_amdgcn_s_waitcnt(0);
        unsigned nloc = b.st[0], nx = b.st[1];
        if (nloc == 0u) { xcd_barrier_complete(bar, b.x, nloc, nx); b.st[0] = nloc; b.st[1] = nx; }
        const unsigned old = xb_add(&bar[XB_XSUB(b.x)], 1u);
        const unsigned gen = old / nloc;
        if (old + 1u == (gen + 1u) * nloc) {
            __builtin_amdgcn_fence(__ATOMIC_RELEASE, "agent");
            asm volatile("s_waitcnt vmcnt(0)" ::: "memory");
            const unsigned og = xb_add(&bar[XB_TOP], 1u);
            const unsigned tg = og / nx;
            if (og + 1u == (tg + 1u) * nx) xb_add(&bar[XB_TOPGEN], 1u);
            else XB_SPIN(xb_ld(&bar[XB_TOPGEN]) == tg, bar);
            __builtin_amdgcn_fence(__ATOMIC_ACQUIRE, "agent");
            xb_add(&bar[XB_XGEN(b.x)], 1u);
            asm volatile("s_waitcnt vmcnt(0)" ::: "memory");
        } else {
            XB_SPIN(xb_ld(&bar[XB_XGEN(b.x)]) == gen, bar);
            __builtin_amdgcn_fence(__ATOMIC_ACQUIRE, "agent");
            asm volatile("s_waitcnt vmcnt(0)" ::: "memory");
        }
    }
    __syncthreads();
}

struct Frame {
    LAS unsigned char* lds;
    int tid, lane, wave, vcu, G;
    const float *x, *c, *w_ada, *b_ada, *w_in, *conv_w, *conv_norm_w, *dn_conv_w, *dn_A_log, *dn_dt_bias, *dn_norm_w, *w_out, *ln1_g, *ln1_b,
                *w_grp, *b_grp, *w_exp, *b_exp, *w_gate, *w_up, *w_down, *ln2_g, *ln2_b;
    float* out; unsigned char* ws; int flags;
};

__device__ __forceinline__ void transpose_item(const float* W, int ldw, int k0, int n0, bf16* WT, int ldt, int drow0, LAS float* scr, int lane) {
#pragma unroll 8
    for (int i = 0; i < 32; ++i) { const int kk = 2 * i + (lane >> 5); scr[kk * 33 + (lane & 31)] = W[(size_t)(k0 + kk) * ldw + n0 + (lane & 31)]; }
    LDS_WAIT(); asm volatile("" ::: "memory");
    const int c = lane & 7;
#pragma unroll
    for (int j = 0; j < 4; ++j) { const int n = (lane >> 3) + 8 * j; const LAS float* s = scr + (8 * c) * 33 + n;
        v4u o; o.x = pk2(s[0 * 33], s[1 * 33]); o.y = pk2(s[2 * 33], s[3 * 33]); o.z = pk2(s[4 * 33], s[5 * 33]); o.w = pk2(s[6 * 33], s[7 * 33]);
        *(GAS v4u*)(WT + (size_t)(drow0 + n) * ldt + k0 + 8 * c) = o; }
    LDS_WAIT(); asm volatile("" ::: "memory");
}
__device__ __forceinline__ void weight_copies(Frame& F, const int it0, const int it1, const int gw, const int ngw) {
    LAS float* scr = (LAS float*)(F.lds + F.wave * 16384);
    constexpr int I_IN = 16 * (NMAIN / 32), I_OUT = 16 * 32, I_G = NE * 16 * 8;
    bf16* WIN = (bf16*)(F.ws + WS_WIN); bf16* WOUT = (bf16*)(F.ws + WS_WOUT); bf16* WGU = (bf16*)(F.ws + WS_WGU); bf16* WD = (bf16*)(F.ws + WS_WD);
    for (int it = it0 + gw; it < it1; it += ngw) {
        int r = it;
        if (r < I_IN) { const int kb = r / (NMAIN / 32), nb = r % (NMAIN / 32); transpose_item(F.w_in, DIN, 64 * kb, 32 * nb, WIN, D, 32 * nb, scr, F.lane); continue; } r -= I_IN;
        if (r < I_OUT) { const int kb = r / 32, nb = r % 32; transpose_item(F.w_out, D, 64 * kb, 32 * nb, WOUT, D, 32 * nb, scr, F.lane); continue; } r -= I_OUT;
        if (r < 2 * I_G) { const int up = r / I_G; r -= up * I_G; const int e = r / 128, kb = (r % 128) / 8, nb = r % 8, n0 = 32 * nb;
            transpose_item((up ? F.w_up : F.w_gate) + (size_t)e * D * DE, DE, 64 * kb, n0, WGU + (size_t)e * 512 * D, D, (n0 / 128) * 256 + up * 128 + (n0 % 128), scr, F.lane); continue; } r -= 2 * I_G;
        { const int e = r / 128, kb = (r % 128) / 32, nb = r % 32; transpose_item(F.w_down + (size_t)e * DE * D, D, 64 * kb, 32 * nb, WD + (size_t)e * D * DE, DE, 32 * nb, scr, F.lane); }
    }
}
constexpr int W_ITEMS_IN = 16 * (NMAIN / 32), W_ITEMS_ALL = 16 * (NMAIN / 32) + 16 * 32 + 2 * NE * 16 * 8 + NE * 4 * 32;
__device__ __forceinline__ void p0_prologue(Frame& F) {
#ifdef EXP_FILL
    {
        const size_t gt = (size_t)blockIdx.x * NTHR + F.tid, gn = (size_t)F.G * NTHR;
        GAS v4u* w0 = (GAS v4u*)(F.ws + (3 * MiB) / 2); for (size_t i = gt; i < (12 * MiB - (3 * MiB) / 2) / 16; i += gn) w0[i] = (v4u){0u, 0u, 0u, 0u};
        GAS v4u* w1 = (GAS v4u*)(F.ws + 72 * MiB); for (size_t i = gt; i < (432 * MiB) / 16; i += gn) w1[i] = (v4u){0u, 0u, 0u, 0u};
    }
#endif
    if (blockIdx.x < 96) {
        LAS float* sc = (LAS float*)(F.lds);
        LAS float* red = (LAS float*)(F.lds + 65536);
#pragma unroll
        for (int it = 0; it < 8; ++it) { const int i4 = F.tid + NTHR * it, b = i4 >> 8, k = (i4 & 255) * 4; const f32x4 v = *(const f32x4*)(F.c + 4 * i4);
            sc[k * 16 + b] = siluf(v.x); sc[(k + 1) * 16 + b] = siluf(v.y); sc[(k + 2) * 16 + b] = siluf(v.z); sc[(k + 3) * 16 + b] = siluf(v.w); }
        __syncthreads();
        const int col = blockIdx.x * 64 + F.lane, kbeg = F.wave * 128;
        float acc[16];
#pragma unroll
        for (int b = 0; b < 16; ++b) acc[b] = 0.f;
#pragma unroll 4
        for (int k = kbeg; k < kbeg + 128; ++k) {
            const float w = F.w_ada[(size_t)k * 6144 + col];
            const LAS f32x4* s4 = (const LAS f32x4*)(sc + k * 16);
#pragma unroll
            for (int q = 0; q < 4; ++q) { const f32x4 s = s4[q]; acc[4 * q] += s.x * w; acc[4 * q + 1] += s.y * w; acc[4 * q + 2] += s.z * w; acc[4 * q + 3] += s.w * w; }
        }
#pragma unroll
        for (int b = 0; b < 16; ++b) red[(F.wave * 16 + b) * 64 + F.lane] = acc[b];
        __syncthreads();
        for (int o = F.tid; o < 1024; o += NTHR) { const int b = o >> 6, l = o & 63; float s = 0.f;
#pragma unroll
            for (int w = 0; w < 8; ++w) s += red[(w * 16 + b) * 64 + l];
            const int cc = blockIdx.x * 64 + l;
            ((float*)(F.ws + WS_MOD))[b * 6144 + cc] = s + F.b_ada[cc]; }
        __syncthreads();
    }
    weight_copies(F, 0, 16 * (NMAIN / 32), F.vcu * NWAVES + F.wave, F.G * NWAVES);
}

__device__ __forceinline__ void p1_modulate(Frame& F) {
    LAS float* wx = (LAS float*)(F.lds);
#pragma unroll
    for (int it = 0; it < 4; ++it) { const int i4 = F.tid + NTHR * it, k = i4 >> 1, hf = i4 & 1, j = k >> 8, l = (k >> 2) & 63, e = k & 3;
        *(LAS f32x4*)(wx + ((hf * 16 + (j * 4 + e)) * 64 + l) * 4) = *(const f32x4*)(F.w_in + (size_t)k * DIN + NMAIN + 4 * hf); }
    __syncthreads();
    const float* MOD = (const float*)(F.ws + WS_MOD);
    bf16* H1 = (bf16*)(F.ws + WS_R1); float* BA = (float*)(F.ws + WS_BA);
    for (int gw = F.vcu * NWAVES + F.wave; gw < T / 16; gw += F.G * NWAVES) {
    const int m0 = gw * 16, b = m0 >> 11;
    f32x4 sc[4], sh[4];
#pragma unroll
    for (int j = 0; j < 4; ++j) { sh[j] = *(const f32x4*)(MOD + b * 6144 + 256 * j + 4 * F.lane); sc[j] = *(const f32x4*)(MOD + b * 6144 + D + 256 * j + 4 * F.lane); }
    for (int r = 0; r < 16; ++r) {
        const int m = m0 + r;
        const GAS f32x4* xr = (const GAS f32x4*)(F.x + (size_t)m * D) + F.lane;
        f32x4 h[4];
#pragma unroll
        for (int j = 0; j < 4; ++j) { const f32x4 v = xr[64 * j]; h[j] = v * (sc[j] + 1.0f) + sh[j]; }
        GAS unsigned long long* o8 = (GAS unsigned long long*)(H1 + (size_t)m * D) + F.lane;
#pragma unroll
        for (int j = 0; j < 4; ++j) o8[64 * j] = (unsigned long long)pk2(h[j].x, h[j].y) | ((unsigned long long)pk2(h[j].z, h[j].w) << 32);
        float a[8];
#pragma unroll
        for (int o = 0; o < 8; ++o) a[o] = 0.f;
#pragma unroll
        for (int j = 0; j < 4; ++j)
#pragma unroll
            for (int e = 0; e < 4; ++e) { const float hv = h[j][e];
                const f32x4 w0 = *(const LAS f32x4*)(wx + ((0 * 16 + (j * 4 + e)) * 64 + F.lane) * 4), w1 = *(const LAS f32x4*)(wx + ((1 * 16 + (j * 4 + e)) * 64 + F.lane) * 4);
                a[0] += hv * w0.x; a[1] += hv * w0.y; a[2] += hv * w0.z; a[3] += hv * w0.w; a[4] += hv * w1.x; a[5] += hv * w1.y; a[6] += hv * w1.z; a[7] += hv * w1.w; }
#pragma unroll
        for (int o = 0; o < 8; ++o) a[o] = wave_sum(a[o]);
        if (F.lane == 0) { *(f32x4*)(BA + (size_t)m * 8) = (f32x4){a[0], a[1], a[2], a[3]}; *(f32x4*)(BA + (size_t)m * 8 + 4) = (f32x4){a[4], a[5], a[6], a[7]}; }
    }
    }
}

struct EpiP {
    static constexpr bool PERM = true;
    unsigned char* ws;
    __device__ __forceinline__ void operator()(const f32x4 (&acc)[2][2][4][2], const pg8::Unit& u, int wr, int wc, int fr, int fq) const {
        const int pm = u.i0, pn = u.i1;
        bf16* base; int ldc, colt;
        if (pn < 6) { base = (bf16*)(ws + WS_PBCU); ldc = 1536; colt = pn * 256; }
        else if (pn < 12) { base = (bf16*)(ws + WS_PQKV); ldc = 1536; colt = (pn - 6) * 256; }
        else { base = (bf16*)(ws + WS_PZ); ldc = 512; colt = (pn - 12) * 256; }
        const int row0 = pm * 256 + wr * 64 + fr, col0 = colt + wc * 32 + 8 * fq;
#pragma unroll
        for (int ai = 0; ai < 2; ++ai)
#pragma unroll
            for (int m = 0; m < 4; ++m) { bf16* rowp = base + (size_t)(row0 + ai * 128 + m * 16) * ldc + col0;
#pragma unroll
                for (int bj = 0; bj < 2; ++bj) { f32x4 v0 = acc[ai][bj][m][0], v1 = acc[ai][bj][m][1];
                    if (pn >= 12) {
#pragma unroll
                        for (int e = 0; e < 4; ++e) { v0[e] = siluf(v0[e]); v1[e] = siluf(v1[e]); } }
                    v4u w; w.x = pg8::cvt_pk_bf16(v0[0], v0[1]); w.y = pg8::cvt_pk_bf16(v0[2], v0[3]); w.z = pg8::cvt_pk_bf16(v1[0], v1[1]); w.w = pg8::cvt_pk_bf16(v1[2], v1[3]);
                    *(v4u*)(rowp + bj * 128) = w; } }
    }
};
struct EpiBf {
    static constexpr bool PERM = true;
    bf16* O; int ldc;
    __device__ __forceinline__ void operator()(const f32x4 (&acc)[2][2][4][2], const pg8::Unit& u, int wr, int wc, int fr, int fq) const {
        const int row0 = u.i0 * 256 + wr * 64 + fr, col0 = u.i1 * 256 + wc * 32 + 8 * fq;
#pragma unroll
        for (int ai = 0; ai < 2; ++ai)
#pragma unroll
            for (int m = 0; m < 4; ++m) { bf16* rowp = O + (size_t)(row0 + ai * 128 + m * 16) * ldc + col0;
#pragma unroll
                for (int bj = 0; bj < 2; ++bj) { const f32x4 v0 = acc[ai][bj][m][0], v1 = acc[ai][bj][m][1];
                    v4u w; w.x = pg8::cvt_pk_bf16(v0[0], v0[1]); w.y = pg8::cvt_pk_bf16(v0[2], v0[3]); w.z = pg8::cvt_pk_bf16(v1[0], v1[1]); w.w = pg8::cvt_pk_bf16(v1[2], v1[3]);
                    *(v4u*)(rowp + bj * 128) = w; } }
    }
};

__device__ __forceinline__ void unpack8(const v4u w, float (&f)[8]) { f[0] = bflo(w.x); f[1] = bfhi(w.x); f[2] = bflo(w.y); f[3] = bfhi(w.y); f[4] = bflo(w.z); f[5] = bfhi(w.z); f[6] = bflo(w.w); f[7] = bfhi(w.w); }
__device__ __forceinline__ void p3a_convmix(Frame& F, const int gw0, const int ngw) {
    const bf16* P = (const bf16*)(F.ws + WS_PBCU); bf16* Y = (bf16*)(F.ws + WS_R1);
    const int ch = 8 * F.lane;
    float w0[8], w1[8], w2[8], nw[8];
#pragma unroll
    for (int e = 0; e < 8; ++e) { w0[e] = F.conv_w[ch + e]; w1[e] = F.conv_w[DC + ch + e]; w2[e] = F.conv_w[2 * DC + ch + e]; nw[e] = F.conv_norm_w[ch + e]; }
    for (int gw = gw0; gw < T / 16; gw += ngw) {
    const int m0 = gw * 16, t0 = m0 & (SEQ - 1);
    float p1[8], p2[8];
#pragma unroll
    for (int e = 0; e < 8; ++e) { p1[e] = 0.f; p2[e] = 0.f; }
    if (t0 != 0) {
        float c1[8], u1[8], c2[8], u2[8];
        unpack8(*(const GAS v4u*)(P + (size_t)(m0 - 1) * 1536 + 512 + ch), c1); unpack8(*(const GAS v4u*)(P + (size_t)(m0 - 1) * 1536 + 1024 + ch), u1);
        unpack8(*(const GAS v4u*)(P + (size_t)(m0 - 2) * 1536 + 512 + ch), c2); unpack8(*(const GAS v4u*)(P + (size_t)(m0 - 2) * 1536 + 1024 + ch), u2);
#pragma unroll
        for (int e = 0; e < 8; ++e) { p1[e] = c1[e] * u1[e]; p2[e] = c2[e] * u2[e]; }
    }
#pragma unroll 4
    for (int r = 0; r < 16; ++r) {
        const int m = m0 + r;
        float bb[8], cc[8], uu[8];
        unpack8(*(const GAS v4u*)(P + (size_t)m * 1536 + ch), bb); unpack8(*(const GAS v4u*)(P + (size_t)m * 1536 + 512 + ch), cc); unpack8(*(const GAS v4u*)(P + (size_t)m * 1536 + 1024 + ch), uu);
        float y[8]; float ss = 0.f;
#pragma unroll
        for (int e = 0; e < 8; ++e) { const float cu = cc[e] * uu[e]; y[e] = bb[e] * (w0[e] * p2[e] + w1[e] * p1[e] + w2[e] * cu); p2[e] = p1[e]; p1[e] = cu; ss += y[e] * y[e]; }
        ss = sum8(ss);
        const float rr = __builtin_amdgcn_rsqf(ss * (1.0f / 64.0f) + RMS_EPS);
        v4u o; o.x = pk2(y[0] * rr * nw[0], y[1] * rr * nw[1]); o.y = pk2(y[2] * rr * nw[2], y[3] * rr * nw[3]); o.z = pk2(y[4] * rr * nw[4], y[5] * rr * nw[5]); o.w = pk2(y[6] * rr * nw[6], y[7] * rr * nw[7]);
        *(GAS v4u*)(Y + (size_t)m * D + ch) = o;
    }
    }
}
#if LEVEL < 3
__device__ __forceinline__ void zero_ydelta(Frame& F) {
    bf16* Y = (bf16*)(F.ws + WS_R1);
    for (int gw = F.vcu * NWAVES + F.wave; gw < T / 16; gw += F.G * NWAVES)
    for (int r = 0; r < 16; ++r) { const int m = gw * 16 + r; *(GAS v4u*)(Y + (size_t)m * D + 512 + 8 * F.lane) = (v4u){0u, 0u, 0u, 0u}; }
}
#endif

__device__ __forceinline__ int kpos(int x) { const int n = x & 31; return (x & ~31) | (n < 16 ? 8 * (n >> 2) + (n & 3) : 8 * ((n - 16) >> 2) + 4 + (n & 3)); }
constexpr int PL_KB = 0, PL_QB = 17408, PL_VB = 34816, PL_KT = 52224, PL_AB = 70656, PL_AF = 79872, PL_DB = 83968, PL_SM = 86528;
__device__ __forceinline__ bf16x8 ldfrag(const LAS unsigned char* base, int stride, int row, int s, int q);
__device__ __forceinline__ bf16x8 pack8(const f32x4 a, const f32x4 b);
constexpr int PL_WST = 87552;
__device__ __forceinline__ f32x4 dn_tile(const LAS unsigned char* L, int isq, int ti, int tj, int col, int q) {
    const LAS unsigned char* arow = L + (isq ? PL_QB : PL_KB) + (16 * ti + col) * 272 + 16 * q;
    const LAS unsigned char* brow = L + PL_KB + (16 * tj + col) * 272 + 16 * q;
    f32x4 acc = (f32x4){0.f, 0.f, 0.f, 0.f};
#pragma unroll
    for (int s = 0; s < 4; ++s) acc = __builtin_amdgcn_mfma_f32_16x16x32_bf16(*(const LAS bf16x8*)(arow + 64 * s), *(const LAS bf16x8*)(brow + 64 * s), acc, 0, 0, 0);
    return acc;
}
__device__ __forceinline__ void dn_pre(Frame& F) {
    LAS unsigned char* L = F.lds;
    LAS float* sgc = (LAS float*)(L + PL_SM);
    LAS float* sbeta = sgc + 64;
    LAS float* seg = sbeta + 64;
    LAS float* seke = seg + 64;
    const bf16* PQ = (const bf16*)(F.ws + WS_PQKV); const float* BA = (const float*)(F.ws + WS_BA);
    const int wave = F.wave;
    const f32x4 zero4 = (f32x4){0.f, 0.f, 0.f, 0.f};
    if (F.vcu >= NCHUNK_ALL) return;
    const int h = (F.vcu >> 5) & 3;
    const float dtb = F.dn_dt_bias[h], nega = -__expf(F.dn_A_log[h]);
    v4u raw[11]; float pbl = 0.f, pal = 0.f;
#define PRE_LOAD(cid_) do { const int n_ = (cid_) & 31, mb_ = ((cid_) >> 7) * SEQ + n_ * CHK; \
        if (tid < 384) { _Pragma("unroll") for (int i = 0; i < 11; ++i) { const int t = ts - 3 + i; const bool ok_ = n_ * CHK + t >= 0; \
            const v4u ld_ = *(const GAS v4u*)(PQ + (size_t)(mb_ + (ok_ ? t : 0)) * 1536 + gcol); raw[i] = ok_ ? ld_ : (v4u){0u, 0u, 0u, 0u}; } }     \
        else if (tid < 448) { pbl = BA[(size_t)(mb_ + (tid & 63)) * 8 + h]; pal = BA[(size_t)(mb_ + (tid & 63)) * 8 + 4 + h]; } } while (0)
    int prev_cid = -1;
    { int tid = threadIdx.x; asm volatile("" : "+v"(tid));
      const int g8 = tid % 48, seg8 = tid / 48, part = g8 >> 4, cc = (g8 & 15) * 8, gcol = part * 512 + h * HD + cc, ts = seg8 * 8;
      PRE_LOAD(F.vcu); }
    for (int cid = F.vcu; cid < NCHUNK_ALL; cid += F.G) {
        int tid = threadIdx.x; asm volatile("" : "+v"(tid));
        const int g8 = tid % 48, seg8 = tid / 48, part = g8 >> 4, cc = (g8 & 15) * 8, gcol = part * 512 + h * HD + cc, ts = seg8 * 8;
        if (tid < 384) {
            float cw[4][8];
#pragma unroll
            for (int k = 0; k < 4; ++k) { const f32x4 c0 = *(const f32x4*)(F.dn_conv_w + k * 1536 + gcol), c1 = *(const f32x4*)(F.dn_conv_w + k * 1536 + gcol + 4);
                cw[k][0] = c0.x; cw[k][1] = c0.y; cw[k][2] = c0.z; cw[k][3] = c0.w; cw[k][4] = c1.x; cw[k][5] = c1.y; cw[k][6] = c1.z; cw[k][7] = c1.w; }
            LAS unsigned char* dst = L + (part == 0 ? PL_QB : (part == 1 ? PL_KB : PL_VB)) + cc * 2;
            float r0[8], r1[8], r2[8];
            unpack8(raw[0], r0); unpack8(raw[1], r1); unpack8(raw[2], r2);
#pragma unroll
            for (int tp = 0; tp < 4; ++tp) {
                float ra[8], rb[8], oa[8], ob[8];
                unpack8(raw[2 * tp + 3], ra); unpack8(raw[2 * tp + 4], rb);
#pragma unroll
                for (int e = 0; e < 8; ++e) { oa[e] = siluf(cw[0][e] * r0[e] + cw[1][e] * r1[e] + cw[2][e] * r2[e] + cw[3][e] * ra[e]);
                    ob[e] = siluf(cw[0][e] * r1[e] + cw[1][e] * r2[e] + cw[2][e] * ra[e] + cw[3][e] * rb[e]); r0[e] = r2[e]; r1[e] = ra[e]; r2[e] = rb[e]; }
                if (part < 2) {
                    float sa = 0.f, sb = 0.f;
#pragma unroll
                    for (int e = 0; e < 8; ++e) { sa += oa[e] * oa[e]; sb += ob[e] * ob[e]; }
                    sa = sum16(sa); sb = sum16(sb);
                    const float sc_ = part == 0 ? 0.08838834764831845f : 1.0f;
                    const float rsa = (__builtin_amdgcn_rsqf(sa + RMS_EPS)) * sc_, rsb = (__builtin_amdgcn_rsqf(sb + RMS_EPS)) * sc_;
#pragma unroll
                    for (int e = 0; e < 8; ++e) { oa[e] *= rsa; ob[e] *= rsb; }
                }
                *(LAS v4u*)(dst + (ts + 2 * tp) * 272) = (v4u){pk2(oa[0], oa[1]), pk2(oa[2], oa[3]), pk2(oa[4], oa[5]), pk2(oa[6], oa[7])};
                *(LAS v4u*)(dst + (ts + 2 * tp + 1) * 272) = (v4u){pk2(ob[0], ob[1]), pk2(ob[2], ob[3]), pk2(ob[4], ob[5]), pk2(ob[6], ob[7])};
                if (part == 1) {
#pragma unroll
                    for (int e = 0; e < 8; ++e) *(LAS unsigned*)(L + PL_KT + (cc + e) * 144 + (ts + 2 * tp) * 2) = pk2(oa[e], ob[e]);
                }
                __builtin_amdgcn_sched_barrier(0);
            }
        } else if (tid < 448) {
            const int i = tid & 63;
            const float beta = __builtin_amdgcn_rcpf(1.0f + __expf(-pbl));
            const float xx = pal + dtb;
            const float sp = xx > 20.f ? xx : log1pf(__expf(xx));
            float v = nega * sp;
#pragma unroll
            for (int o = 1; o < 64; o <<= 1) { const float tq = __shfl_up(v, o); if (i >= o) v += tq; }
            const float g63 = __shfl(v, 63);
            sgc[i] = v; sbeta[i] = beta; seg[i] = __expf(v); seke[i] = __expf(g63 - v);
            if (i == 63) ((float*)(F.ws + WS_DEC))[cid] = __expf(v);
        }
        if (cid + F.G < NCHUNK_ALL) PRE_LOAD(cid + F.G);
        __syncthreads();
        { int t2_ = threadIdx.x; asm volatile("" : "+v"(t2_)); tid = t2_; }
        const int lane = tid & 63, col = lane & 15, q = lane >> 4;
        bf16* G = (bf16*)(F.ws + WS_DNG) + (size_t)cid * 4096;
        if (wave < 4) {
            const int t = wave;
            {
                const f32x4 acc = dn_tile(L, 0, t, t, col, q);
                const int j = 16 * t + col; const float gj = sgc[j];
                int a[4];
#pragma unroll
                for (int r = 0; r < 4; ++r) { const int i = 16 * t + 4 * q + r; a[r] = __builtin_bit_cast(int, (i > j) ? sbeta[i] * acc[r] * __expf(sgc[i] - gj) : 0.f);
                    *(LAS bf16*)(L + PL_AB + i * 144 + kpos(j) * 2) = (bf16)0; }
                float x[16];
#pragma unroll
                for (int rr = 0; rr < 16; ++rr) { float xa = (rr == col) ? 1.0f : 0.0f;
#pragma unroll
                    for (int jj = 0; jj < rr; ++jj) xa -= __builtin_bit_cast(float, __builtin_amdgcn_readlane(a[rr & 3], 16 * (rr >> 2) + jj)) * x[jj];
                    x[rr] = xa;
                    if (q == 0) *(LAS bf16*)(L + PL_DB + t * 640 + rr * 40 + col * 2) = (bf16)f2bf(xa);
                    __builtin_amdgcn_sched_barrier(0); }
            }
            {
                const f32x4 acc = dn_tile(L, 1, t, t, col, q);
                const int j = 16 * t + col; const float gj = sgc[j];
#pragma unroll
                for (int r = 0; r < 4; ++r) { const int i = 16 * t + 4 * q + r; G[i * 64 + kpos(j)] = (bf16)f2bf(i >= j ? acc[r] * __expf(sgc[i] - gj) : 0.f); }
            }
        } else {
#pragma unroll 1
            for (int it = 0; it < 3; ++it) {
                const int idx = (wave - 4) + 4 * it, isq = idx >= 6 ? 1 : 0, p = idx - 6 * isq;
                const int ti = p < 1 ? 1 : (p < 3 ? 2 : 3), tj = p - (ti == 1 ? 0 : (ti == 2 ? 1 : 3));
                const f32x4 acc = dn_tile(L, isq, ti, tj, col, q);
                const int j = 16 * tj + col; const float gj = sgc[j];
#pragma unroll
                for (int r = 0; r < 4; ++r) { const int i = 16 * ti + 4 * q + r; const float dcy = __expf(sgc[i] - gj);
                    if (isq) G[i * 64 + kpos(j)] = (bf16)f2bf(acc[r] * dcy);
                    else *(LAS bf16*)(L + PL_AB + i * 144 + kpos(j) * 2) = (bf16)f2bf(sbeta[i] * acc[r] * dcy); }
            }
            if (wave < 7) {
#pragma unroll
                for (int z = 0; z < 2; ++z) { const int uidx = (wave - 4) * 2 + z; const int ti = uidx < 3 ? 0 : (uidx < 5 ? 1 : 2), tj = uidx < 3 ? uidx + 1 : (uidx < 5 ? uidx - 1 : 3);
#pragma unroll
                    for (int r = 0; r < 4; ++r) G[(16 * ti + 4 * q + r) * 64 + kpos(16 * tj + col)] = (bf16)0; }
            }
        }
        { bf16* Q = (bf16*)(F.ws + WS_DNQ) + (size_t)cid * 8192; bf16* KT = (bf16*)(F.ws + WS_DNK) + (size_t)cid * 8192;
#pragma unroll
          for (int r = 0; r < 2; ++r) { const int p = tid + 512 * r, i = p >> 4, c16 = p & 15; float f[8]; unpack8(*(const LAS v4u*)(L + PL_QB + i * 272 + c16 * 16), f); const float sc = seg[i];
              *(GAS v2u*)(Q + i * 128 + kpos(c16 * 8)) = (v2u){pk2(f[0] * sc, f[1] * sc), pk2(f[2] * sc, f[3] * sc)}; *(GAS v2u*)(Q + i * 128 + kpos(c16 * 8 + 4)) = (v2u){pk2(f[4] * sc, f[5] * sc), pk2(f[6] * sc, f[7] * sc)}; }
#pragma unroll
          for (int r = 0; r < 2; ++r) { const int p = tid + 512 * r, d = p >> 3, t8 = p & 7; float f[8]; unpack8(*(const LAS v4u*)(L + PL_KT + d * 144 + t8 * 16), f);
              const f32x4 e0 = *(const LAS f32x4*)(seke + t8 * 8), e1 = *(const LAS f32x4*)(seke + t8 * 8 + 4);
              *(GAS v2u*)(KT + d * 64 + kpos(t8 * 8)) = (v2u){pk2(f[0] * e0.x, f[1] * e0.y), pk2(f[2] * e0.z, f[3] * e0.w)}; *(GAS v2u*)(KT + d * 64 + kpos(t8 * 8 + 4)) = (v2u){pk2(f[4] * e1.x, f[5] * e1.y), pk2(f[6] * e1.z, f[7] * e1.w)}; }
          if (prev_cid >= 0) { bf16* W = (bf16*)(F.ws + WS_DNW) + (size_t)prev_cid * 8192;
#pragma unroll
              for (int r = 0; r < 2; ++r) { const int p = tid + 512 * r, i = p >> 4, c16 = p & 15; *(GAS v4u*)(W + i * 128 + c16 * 8) = *(const LAS v4u*)(L + PL_WST + i * 272 + c16 * 16); } } }
        __syncthreads();
        {
            bf16x8 Dfr[4];
#pragma unroll
            for (int i = 0; i < 4; ++i) { const v2u lo = *(const LAS v2u*)(L + PL_DB + i * 640 + col * 40 + 8 * q); Dfr[i] = __builtin_bit_cast(bf16x8, (v4u){lo.x, lo.y, 0u, 0u}); }
            bf16* U = (bf16*)(F.ws + WS_DNU) + (size_t)cid * 8192;
#pragma unroll
            for (int c2 = 0; c2 < 2; ++c2) {
                const int ct = 2 * wave + c2, isw = ct >= 8 ? 1 : 0, d = (16 * ct + col) & 127;
                const LAS unsigned char* src = L + (isw ? PL_KB : PL_VB) + d * 2;
                f32x4 rhs[4];
#pragma unroll
                for (int i = 0; i < 4; ++i) { const f32x4 bt = *(const LAS f32x4*)(sbeta + 16 * i + 4 * q), eg = *(const LAS f32x4*)(seg + 16 * i + 4 * q);
#pragma unroll
                    for (int r = 0; r < 4; ++r) rhs[i][r] = bf1(*(const LAS bf16*)(src + (16 * i + 4 * q + r) * 272)) * bt[r] * (isw ? eg[r] : 1.0f); }
                f32x4 X[4];
                X[0] = __builtin_amdgcn_mfma_f32_16x16x32_bf16(Dfr[0], pack8(rhs[0], zero4), zero4, 0, 0, 0);
                f32x4 y = __builtin_amdgcn_mfma_f32_16x16x32_bf16(ldfrag(L + PL_AB, 144, 16 + col, 0, q), pack8(X[0], zero4), zero4, 0, 0, 0);
                X[1] = __builtin_amdgcn_mfma_f32_16x16x32_bf16(Dfr[1], pack8(rhs[1] - y, zero4), zero4, 0, 0, 0);
                const bf16x8 X01 = pack8(X[0], X[1]);
                y = __builtin_amdgcn_mfma_f32_16x16x32_bf16(ldfrag(L + PL_AB, 144, 32 + col, 0, q), X01, zero4, 0, 0, 0);
                X[2] = __builtin_amdgcn_mfma_f32_16x16x32_bf16(Dfr[2], pack8(rhs[2] - y, zero4), zero4, 0, 0, 0);
                y = __builtin_amdgcn_mfma_f32_16x16x32_bf16(ldfrag(L + PL_AB, 144, 48 + col, 0, q), X01, zero4, 0, 0, 0);
                y = __builtin_amdgcn_mfma_f32_16x16x32_bf16(ldfrag(L + PL_AB, 144, 48 + col, 1, q), pack8(X[2], zero4), y, 0, 0, 0);
                X[3] = __builtin_amdgcn_mfma_f32_16x16x32_bf16(Dfr[3], pack8(rhs[3] - y, zero4), zero4, 0, 0, 0);
                if (!isw) {
#pragma unroll
                    for (int i = 0; i < 4; ++i) *(GAS v2u*)(U + (16 * ct + col) * 64 + 16 * i + 4 * q) = (v2u){pk2(X[i][0], X[i][1]), pk2(X[i][2], X[i][3])};
                } else {
#pragma unroll
                    for (int i = 0; i < 4; ++i)
#pragma unroll
                        for (int r = 0; r < 4; ++r) *(LAS bf16*)(L + PL_WST + (16 * i + 4 * q + r) * 272 + kpos(d) * 2) = (bf16)f2bf(X[i][r]);
                }
            }
        }
        prev_cid = cid;
        __syncthreads();
    }
#undef PRE_LOAD
    int tid = threadIdx.x; asm volatile("" : "+v"(tid));
    if (prev_cid >= 0) { bf16* W = (bf16*)(F.ws + WS_DNW) + (size_t)prev_cid * 8192;
#pragma unroll
        for (int r = 0; r < 2; ++r) { const int p = tid + 512 * r, i = p >> 4, c16 = p & 15; *(GAS v4u*)(W + i * 128 + c16 * 8) = *(const LAS v4u*)(L + PL_WST + i * 272 + c16 * 16); } }
}

__device__ __forceinline__ bf16x8 pack8(const f32x4 a, const f32x4 b) {
    const v4u w = (v4u){pg8::cvt_pk_bf16(a.x, a.y), pg8::cvt_pk_bf16(a.z, a.w), pg8::cvt_pk_bf16(b.x, b.y), pg8::cvt_pk_bf16(b.z, b.w)};
    return __builtin_bit_cast(bf16x8, w);
}
__device__ __forceinline__ bf16x8 ldfrag(const LAS unsigned char* base, int stride, int row, int s, int q) {
    return *(const LAS bf16x8*)(base + row * stride + 64 * s + 16 * q);
}
__device__ __forceinline__ void dn_scan(Frame& F) {
    if (blockIdx.x >= NB * NH) return;
    const int item = blockIdx.x, b = item >> 2, h = item & 3;
    int tid = threadIdx.x; asm volatile("" : "+v"(tid));
    const int lane = tid & 63, wave = F.wave, col = lane & 15, q = lane >> 4, c0 = wave * 16;
    LAS unsigned char* L = F.lds;
    constexpr int WL = 0, QL = 17408, KL = 34816, GL = 53248, BUFB = 62464;
    f32x4 S[8];
#pragma unroll
    for (int i = 0; i < 8; ++i) S[i] = (f32x4){0.f, 0.f, 0.f, 0.f};
    const bf16* PZ = (const bf16*)(F.ws + WS_PZ); bf16* Y = (bf16*)(F.ws + WS_R1);
    const int otok = tid >> 3, oseg = tid & 7;
    unsigned soff[8];
#pragma unroll
    for (int j = 0; j < 8; ++j) { const int k = (wave + 8 * j) < 61 ? (wave + 8 * j) : 60; int o = 0;
        if (k < 34) { const int p = 64 * (k < 17 ? k : k - 17) + lane, row = p / 17, c = p % 17; o = row * 256 + (c < 15 ? c : 15) * 16; }
        else if (k < 61) { const int p = 64 * (k < 52 ? k - 34 : k - 52) + lane, row = p / 9, c = p % 9; o = row * 128 + (c < 7 ? c : 7) * 16; }
        soff[j] = (unsigned)o; }
    LAS float* nwl = (LAS float*)(L + 2 * BUFB);
    if (tid < HD) nwl[tid] = F.dn_norm_w[tid];
    int zero; asm volatile("v_mov_b32 %0, 0" : "=v"(zero));
    size_t gb0[8]; int gst[8], kk[8];
#pragma unroll
    for (int j = 0; j < 8; ++j) { const int k = (wave + 8 * j) < 61 ? (wave + 8 * j) : 60; kk[j] = k;
        gb0[j] = k < 17 ? WS_DNW : (k < 34 ? WS_DNQ : (k < 52 ? WS_DNK : WS_DNG)); gst[j] = k < 52 ? 16384 : 8192; }
#define SCAN_DMA(n_, buf_) do { const int cid_ = item * 32 + (n_); \
        _Pragma("unroll") for (int j = 0; j < 8; ++j) \
            __builtin_amdgcn_global_load_lds((const unsigned*)(F.ws + gb0[j] + (size_t)cid_ * gst[j] + soff[j]), (LAS unsigned*)(L + (buf_) * BUFB + kk[j] * 1024), 16, 0, 0); } while (0)
    v2u pu[4]; v4u pz[2]; float pdec;
#define SCAN_LOAD(n_) do { const int cid_ = item * 32 + (n_); \
        const bf16* up_ = (const bf16*)(F.ws + WS_DNU) + ((size_t)cid_ * 128 + c0 + col) * 64 + 4 * q; \
        _Pragma("unroll") for (int mt = 0; mt < 4; ++mt) pu[mt] = *(const GAS v2u*)(up_ + 16 * mt); \
        const bf16* zp_ = PZ + (size_t)(b * SEQ + (n_) * CHK + otok) * 512 + h * HD + 16 * oseg; \
        pz[0] = *(const GAS v4u*)zp_; pz[1] = *(const GAS v4u*)(zp_ + 8); \
        pdec = ((const float*)(F.ws + WS_DEC))[cid_ + zero]; } while (0)
    LAS unsigned char* STB = L + 2 * BUFB + 512;
    asm volatile("s_waitcnt lgkmcnt(0)" ::: "memory");
    SCAN_DMA(0, 0); SCAN_LOAD(0);
    v4u zprev[2] = {(v4u){0u, 0u, 0u, 0u}, (v4u){0u, 0u, 0u, 0u}};
#pragma unroll 1
    for (int n = 0; n <= NCHUNK; ++n) {
        const int bsel = n & 1;
        const LAS unsigned char* LB = L + bsel * BUFB;
        asm volatile("s_waitcnt vmcnt(0)" ::: "memory"); __builtin_amdgcn_s_barrier(); asm volatile("" ::: "memory");
        v2u cu[4]; v4u cz[2]; float dec = pdec; asm volatile("" : "+v"(dec));
#pragma unroll
        for (int mt = 0; mt < 4; ++mt) { cu[mt] = pu[mt]; asm volatile("" : "+v"(cu[mt])); }
        cz[0] = pz[0]; cz[1] = pz[1]; asm volatile("" : "+v"(cz[0]), "+v"(cz[1]));
        if (n + 1 < NCHUNK) { if (!(F.flags & 1)) SCAN_DMA(n + 1, bsel ^ 1); SCAN_LOAD(n + 1); }
        if (n > 0 && !(F.flags & 4)) {
            float ov_[16]; float ss = 0.f;
            { float t8[8]; unpack8(*(const LAS v4u*)(STB + otok * 272 + 32 * oseg), t8);
#pragma unroll
              for (int e = 0; e < 8; ++e) { ov_[e] = t8[e]; ss += t8[e] * t8[e]; }
              unpack8(*(const LAS v4u*)(STB + otok * 272 + 32 * oseg + 16), t8);
#pragma unroll
              for (int e = 0; e < 8; ++e) { ov_[8 + e] = t8[e]; ss += t8[e] * t8[e]; } }
            ss = sum8(ss);
            const float rstd = __builtin_amdgcn_rsqf(ss * (1.0f / HD) + RMS_EPS);
            float zf[16]; { float t8[8]; unpack8(zprev[0], t8);
#pragma unroll
              for (int e = 0; e < 8; ++e) zf[e] = t8[e];
              unpack8(zprev[1], t8);
#pragma unroll
              for (int e = 0; e < 8; ++e) zf[8 + e] = t8[e]; }
            unsigned w8[8];
            float nwv[16];
#pragma unroll
            for (int e = 0; e < 4; ++e) { const f32x4 t = *(const LAS f32x4*)(nwl + 16 * oseg + 4 * e); nwv[4 * e] = t.x; nwv[4 * e + 1] = t.y; nwv[4 * e + 2] = t.z; nwv[4 * e + 3] = t.w; }
#pragma unroll
            for (int e = 0; e < 8; ++e) w8[e] = pk2(ov_[2 * e] * rstd * nwv[2 * e] * zf[2 * e], ov_[2 * e + 1] * rstd * nwv[2 * e + 1] * zf[2 * e + 1]);
            bf16* yp = Y + (size_t)(b * SEQ + (n - 1) * CHK + otok) * D + DD + h * HD + 16 * oseg;
            *(GAS v4u*)yp = (v4u){w8[0], w8[1], w8[2], w8[3]}; *(GAS v4u*)(yp + 8) = (v4u){w8[4], w8[5], w8[6], w8[7]};
        }
        zprev[0] = cz[0]; zprev[1] = cz[1];
        if (n == NCHUNK) break;
        bf16x8 Sb[4];
#pragma unroll
        for (int s = 0; s < 4; ++s) Sb[s] = pack8(S[2 * s], S[2 * s + 1]);
        f32x4 o[4];
#pragma unroll
        for (int mt = 0; mt < 4; ++mt) o[mt] = (f32x4){0.f, 0.f, 0.f, 0.f};
        if (!(F.flags & 2)) {
        const f32x4 z4 = (f32x4){0.f, 0.f, 0.f, 0.f};
        bf16x8 fr[16];
        f32x4 dl[4];
#pragma unroll
        for (int mt = 0; mt < 4; ++mt)
#pragma unroll
            for (int s = 0; s < 4; ++s) fr[mt * 4 + s] = ldfrag(LB + WL, 272, 16 * mt + col, s, q);
        __builtin_amdgcn_sched_barrier(0);
#pragma unroll
        for (int mt = 0; mt < 4; ++mt) dl[mt] = z4;
#pragma unroll
        for (int s = 0; s < 4; ++s)
#pragma unroll
            for (int mt = 0; mt < 4; ++mt) dl[mt] = __builtin_amdgcn_mfma_f32_16x16x32_bf16(fr[mt * 4 + s], Sb[s], dl[mt], 0, 0, 0);
#pragma unroll
        for (int mt = 0; mt < 4; ++mt)
#pragma unroll
            for (int s = 0; s < 4; ++s) fr[mt * 4 + s] = ldfrag(LB + QL, 272, 16 * mt + col, s, q);
        __builtin_amdgcn_sched_barrier(0);
#pragma unroll
        for (int mt = 0; mt < 4; ++mt) dl[mt] = (f32x4){bflo(cu[mt].x), bfhi(cu[mt].x), bflo(cu[mt].y), bfhi(cu[mt].y)} - dl[mt];
        bf16x8 Db[2];
#pragma unroll
        for (int s2 = 0; s2 < 2; ++s2) Db[s2] = pack8(dl[2 * s2], dl[2 * s2 + 1]);
#pragma unroll
        for (int s = 0; s < 4; ++s)
#pragma unroll
            for (int mt = 0; mt < 4; ++mt) o[mt] = __builtin_amdgcn_mfma_f32_16x16x32_bf16(fr[mt * 4 + s], Sb[s], o[mt], 0, 0, 0);
        fr[0] = ldfrag(LB + GL, 144, col, 0, q); fr[1] = ldfrag(LB + GL, 144, 16 + col, 0, q); fr[2] = ldfrag(LB + GL, 144, 32 + col, 0, q);
        fr[3] = ldfrag(LB + GL, 144, 32 + col, 1, q); fr[4] = ldfrag(LB + GL, 144, 48 + col, 0, q); fr[5] = ldfrag(LB + GL, 144, 48 + col, 1, q);
        __builtin_amdgcn_sched_barrier(0);
        o[0] = __builtin_amdgcn_mfma_f32_16x16x32_bf16(fr[0], Db[0], o[0], 0, 0, 0); o[1] = __builtin_amdgcn_mfma_f32_16x16x32_bf16(fr[1], Db[0], o[1], 0, 0, 0);
        o[2] = __builtin_amdgcn_mfma_f32_16x16x32_bf16(fr[2], Db[0], o[2], 0, 0, 0); o[3] = __builtin_amdgcn_mfma_f32_16x16x32_bf16(fr[4], Db[0], o[3], 0, 0, 0);
        o[2] = __builtin_amdgcn_mfma_f32_16x16x32_bf16(fr[3], Db[1], o[2], 0, 0, 0); o[3] = __builtin_amdgcn_mfma_f32_16x16x32_bf16(fr[5], Db[1], o[3], 0, 0, 0);
#pragma unroll
        for (int m8 = 0; m8 < 8; ++m8)
#pragma unroll
            for (int s2 = 0; s2 < 2; ++s2) fr[m8 * 2 + s2] = ldfrag(LB + KL, 144, 16 * m8 + col, s2, q);
        __builtin_amdgcn_sched_barrier(0);
#pragma unroll
        for (int m8 = 0; m8 < 8; ++m8) S[m8] = S[m8] * dec;
#pragma unroll
        for (int s2 = 0; s2 < 2; ++s2)
#pragma unroll
            for (int m8 = 0; m8 < 8; ++m8) S[m8] = __builtin_amdgcn_mfma_f32_16x16x32_bf16(fr[m8 * 2 + s2], Db[s2], S[m8], 0, 0, 0);
        }
        asm volatile("s_waitcnt lgkmcnt(0)" ::: "memory"); __builtin_amdgcn_s_barrier(); asm volatile("" ::: "memory");
#pragma unroll
        for (int mt = 0; mt < 4; ++mt)
#pragma unroll
            for (int r = 0; r < 4; ++r) *(LAS bf16*)(STB + (16 * mt + 4 * q + r) * 272 + (c0 + col) * 2) = (bf16)f2bf(o[mt][r]);
        asm volatile("s_waitcnt lgkmcnt(0)" ::: "memory");
    }
#undef SCAN_LOAD
#undef SCAN_DMA
}

__device__ __forceinline__ void p5_ln1_router(Frame& F) {
#if LEVEL >= 4
    LAS float* wg = (LAS float*)(F.lds);
    LAS float* we = (LAS float*)(F.lds + 16384);
#pragma unroll
    for (int it = 0; it < 2; ++it) { const int k = F.tid + NTHR * it, j = k >> 8, l = (k >> 2) & 63, e = k & 3; *(LAS f32x4*)(wg + ((j * 4 + e) * 64 + l) * 4) = *(const f32x4*)(F.w_grp + 4 * k); }
    { f32x4 t[16];
#pragma unroll
      for (int it = 0; it < 16; ++it) t[it] = *(const f32x4*)(F.w_exp + 4 * (F.tid + NTHR * it));
#pragma unroll
      for (int it = 0; it < 16; ++it) { const int i4 = F.tid + NTHR * it, k = i4 >> 3, c4 = i4 & 7, j = k >> 8, l = (k >> 2) & 63, e = k & 3; *(LAS f32x4*)(we + ((c4 * 16 + (j * 4 + e)) * 64 + l) * 4) = t[it]; } }
    __syncthreads();
#endif
    LAS int* rlist = (LAS int*)(F.lds + LDSCTL_OFF + 2048); LAS int* rhist = rlist + 256; LAS int* rbase = rhist + 32;
    const float* MOD = (const float*)(F.ws + WS_MOD);
    const bf16* MIX = (const bf16*)(F.ws + WS_MIX); bf16* X1 = (bf16*)(F.ws + WS_X1); bf16* H2 = (bf16*)(F.ws + WS_R1);
    for (int bi = F.vcu; bi < T / 128; bi += F.G) {
    const int gw = bi * NWAVES + F.wave;
    const int m0 = gw * 16, b = m0 >> 11;
    f32x4 g1[4], sc2[4], sh2[4], lg[4], lb[4];
#pragma unroll
    for (int j = 0; j < 4; ++j) { const int co = 256 * j + 4 * F.lane;
        g1[j] = *(const f32x4*)(MOD + b * 6144 + 2 * D + co); sh2[j] = *(const f32x4*)(MOD + b * 6144 + 3 * D + co); sc2[j] = *(const f32x4*)(MOD + b * 6144 + 4 * D + co);
        lg[j] = *(const f32x4*)(F.ln1_g + co); lb[j] = *(const f32x4*)(F.ln1_b + co); }
    for (int r = 0; r < 16; ++r) {
        const int m = m0 + r;
        const GAS f32x4* xr = (const GAS f32x4*)(F.x + (size_t)m * D) + F.lane;
        const GAS v2u* mr = (const GAS v2u*)(MIX + (size_t)m * D) + F.lane;
        f32x4 v[4]; float s = 0.f;
#pragma unroll
        for (int j = 0; j < 4; ++j) { const f32x4 xv = xr[64 * j];
#if LEVEL >= 2
            const v2u mw = mr[64 * j]; const f32x4 mv = (f32x4){bflo(mw.x), bfhi(mw.x), bflo(mw.y), bfhi(mw.y)};
            v[j] = xv * ALPHA + g1[j] * mv;
#else
            (void)mr; v[j] = xv * ALPHA;
#endif
            s += (v[j].x + v[j].y) + (v[j].z + v[j].w); }
        const float mean = wave_sum(s) * (1.f / D); float s2 = 0.f;
#pragma unroll
        for (int j = 0; j < 4; ++j) { v[j] = v[j] - mean; s2 += (v[j].x * v[j].x + v[j].y * v[j].y) + (v[j].z * v[j].z + v[j].w * v[j].w); }
        const float rstd = __builtin_amdgcn_rsqf(wave_sum(s2) * (1.f / D) + LN_EPS);
        GAS unsigned long long* x1r = (GAS unsigned long long*)(X1 + (size_t)m * D) + F.lane;
        GAS unsigned long long* o8 = (GAS unsigned long long*)(H2 + (size_t)m * D) + F.lane;
        f32x4 h[4];
#pragma unroll
        for (int j = 0; j < 4; ++j) { const f32x4 x1 = v[j] * rstd * lg[j] + lb[j]; x1r[64 * j] = (unsigned long long)pk2(x1.x, x1.y) | ((unsigned long long)pk2(x1.z, x1.w) << 32); h[j] = x1 * (sc2[j] + 1.0f) + sh2[j];
            o8[64 * j] = (unsigned long long)pk2(h[j].x, h[j].y) | ((unsigned long long)pk2(h[j].z, h[j].w) << 32); }
#if LEVEL >= 4
        float a[4] = {0.f, 0.f, 0.f, 0.f};
#pragma unroll
        for (int j = 0; j < 4; ++j)
#pragma unroll
            for (int e = 0; e < 4; ++e) { const float hv = h[j][e]; const f32x4 w = *(const LAS f32x4*)(wg + ((j * 4 + e) * 64 + F.lane) * 4); a[0] += hv * w.x; a[1] += hv * w.y; a[2] += hv * w.z; a[3] += hv * w.w; }
        int g = 0; float gmax = -3.0e38f, gl[4];
#pragma unroll
        for (int q = 0; q < 4; ++q) { gl[q] = wave_sum(a[q]) + F.b_grp[q]; if (gl[q] > gmax) { gmax = gl[q]; g = q; } }
        g = __builtin_amdgcn_readfirstlane(g);
        float gs = 0.f;
#pragma unroll
        for (int q = 0; q < 4; ++q) gs += __expf(gl[q] - gmax);
        const float grp_w = 1.0f / gs;
        float ea[8];
#pragma unroll
        for (int q = 0; q < 8; ++q) ea[q] = 0.f;
        const LAS float* weg = we + (size_t)g * (2 * 16 * 64 * 4);
#pragma unroll
        for (int j = 0; j < 4; ++j)
#pragma unroll
            for (int e = 0; e < 4; ++e) { const float hv = h[j][e];
                const f32x4 w0 = *(const LAS f32x4*)(weg + ((0 * 16 + (j * 4 + e)) * 64 + F.lane) * 4), w1 = *(const LAS f32x4*)(weg + ((1 * 16 + (j * 4 + e)) * 64 + F.lane) * 4);
                ea[0] += hv * w0.x; ea[1] += hv * w0.y; ea[2] += hv * w0.z; ea[3] += hv * w0.w; ea[4] += hv * w1.x; ea[5] += hv * w1.y; ea[6] += hv * w1.z; ea[7] += hv * w1.w; }
        float el[8]; int i1 = 0; float m1 = -3.0e38f;
#pragma unroll
        for (int q = 0; q < 8; ++q) { el[q] = wave_sum(ea[q]) + F.b_exp[g * 8 + q]; if (el[q] > m1) { m1 = el[q]; i1 = q; } }
        int i2 = 0; float m2 = -3.0e38f;
#pragma unroll
        for (int q = 0; q < 8; ++q) if (q != i1 && el[q] > m2) { m2 = el[q]; i2 = q; }
        const float e2 = __expf(m2 - m1), inv = 1.0f / (1.0f + e2);
        if (F.lane < 2) {
            const int e = g * 8 + (F.lane == 0 ? i1 : i2); const float gate = grp_w * (F.lane == 0 ? inv : e2 * inv);
            ((int*)(F.ws + WS_TOKE))[m * 2 + F.lane] = e; ((float*)(F.ws + WS_TOKG))[m * 2 + F.lane] = gate;
            rlist[(F.wave * 16 + r) * 2 + F.lane] = e;
        }
#endif
    }
#if LEVEL >= 4
    if (F.tid < NE) rhist[F.tid] = 0;
    __syncthreads();
    int my_e = 0, my_l = 0;
    if (F.tid < 256) { my_e = rlist[F.tid]; my_l = (int)__hip_atomic_fetch_add((LAS unsigned*)rhist + my_e, 1u, __ATOMIC_RELAXED, __HIP_MEMORY_SCOPE_WORKGROUP); }
    __syncthreads();
    if (F.tid < NE) { const unsigned c = (unsigned)rhist[F.tid]; rbase[F.tid] = c ? (int)__hip_atomic_fetch_add((unsigned*)(F.ws + WS_CTL) + CW_CNT + 64 * F.tid, c, RLX_AGENT) : 0; }
    __syncthreads();
    if (F.tid < 256) { const int rk = rbase[my_e] + my_l, mm = bi * 128 + (F.tid >> 1);
        ((int*)(F.ws + WS_ELIST))[(size_t)my_e * 65536 + rk] = mm; ((int*)(F.ws + WS_TOKR))[mm * 2 + (F.tid & 1)] = rk; }
    __syncthreads();
#endif
    }
}

constexpr int TS_OFF = LDSCTL_OFF, EC_OFF = LDSCTL_OFF + 256;
__device__ __forceinline__ void moe_tables(Frame& F) {
    LAS int* tstart = (LAS int*)(F.lds + TS_OFF); LAS int* ecnt = (LAS int*)(F.lds + EC_OFF);
    if (F.tid < NE) { unsigned* cnt = (unsigned*)(F.ws + WS_CTL) + CW_CNT;
        const int c = (int)__hip_atomic_load(cnt + 64 * F.tid, RLX_AGENT); ecnt[F.tid] = c;
        LDS_WAIT();
        int acc = 0;
        for (int k = 0; k < NE; ++k) { const int t = (ecnt[k] + 255) >> 8; acc += (k < F.tid) ? t : 0; }
        tstart[F.tid] = acc; if (F.tid == NE - 1) tstart[NE] = acc + ((c + 255) >> 8); }
    __syncthreads();
}
__device__ __forceinline__ int moe_find(const LAS int* tstart, int rt) { int e = 0;
#pragma unroll 1
    for (int k = 1; k < NE; ++k) if (tstart[k] <= rt) e = k;
    return e; }
struct MoeGU {
    static constexpr bool GATHER = true;
    const char* H2; const char* WGU; const LAS int* tstart; const LAS int* xtok; int nunits, G, c;
    __device__ __forceinline__ bool next(int i, pg8::Unit& u) const {
        const int L = i * G + c; if (L >= nunits) return false;
        const int rt = L >> 1, pn = L & 1, e = moe_find(tstart, rt);
        u.a = H2; u.b = WGU + ((size_t)e * 512 + (size_t)pn * 256) * D * 2; u.i0 = rt; u.i1 = pn; u.i2 = e; return true;
    }
    __device__ __forceinline__ void a_off(const pg8::Unit&, int ui, unsigned (&vo)[2][2], const int (&R)[2], const int (&C)[2], int K_) const {
#pragma unroll
        for (int h = 0; h < 2; ++h)
#pragma unroll
            for (int i = 0; i < 2; ++i) vo[h][i] = (unsigned)(xtok[ui * 256 + h * 128 + R[i]] * K_ + C[i]) * 2u;
    }
};
struct MoeDown {
    static constexpr bool GATHER = false;
    const char* HID; const char* WD; const LAS int* tstart; int nunits, G, c;
    __device__ __forceinline__ bool next(int i, pg8::Unit& u) const {
        const int L = i * G + c; if (L >= nunits) return false;
        const int rt = L >> 2, pn = L & 3, e = moe_find(tstart, rt);
        u.a = HID + (size_t)rt * 256 * DE * 2; u.b = WD + ((size_t)e * D + (size_t)pn * 256) * DE * 2; u.i0 = rt; u.i1 = pn; u.i2 = e; return true;
    }
    __device__ __forceinline__ void a_off(const pg8::Unit&, int, unsigned (&vo)[2][2], const int (&R)[2], const int (&C)[2], int K_) const {
#pragma unroll
        for (int h = 0; h < 2; ++h)
#pragma unroll
            for (int i = 0; i < 2; ++i) vo[h][i] = (unsigned)((h * 128 + R[i]) * K_ + C[i]) * 2u;
    }
};
struct EpiGU {
    static constexpr bool PERM = true;
    bf16* HID;
    __device__ __forceinline__ void operator()(const f32x4 (&acc)[2][2][4][2], const pg8::Unit& u, int wr, int wc, int fr, int fq) const {
        const int row0 = u.i0 * 256 + wr * 64 + fr, col0 = u.i1 * 128 + wc * 32 + 8 * fq;
#pragma unroll
        for (int ai = 0; ai < 2; ++ai)
#pragma unroll
            for (int m = 0; m < 4; ++m) { bf16* rowp = HID + (size_t)(row0 + ai * 128 + m * 16) * DE + col0;
                const f32x4 g0 = acc[ai][0][m][0], g1 = acc[ai][0][m][1], u0 = acc[ai][1][m][0], u1 = acc[ai][1][m][1];
                v4u w; w.x = pg8::cvt_pk_bf16(siluf(g0[0]) * u0[0], siluf(g0[1]) * u0[1]); w.y = pg8::cvt_pk_bf16(siluf(g0[2]) * u0[2], siluf(g0[3]) * u0[3]);
                w.z = pg8::cvt_pk_bf16(siluf(g1[0]) * u1[0], siluf(g1[1]) * u1[1]); w.w = pg8::cvt_pk_bf16(siluf(g1[2]) * u1[2], siluf(g1[3]) * u1[3]);
                *(v4u*)rowp = w; }
    }
};
__device__ __forceinline__ void p7_gateup(Frame& F) {
    moe_tables(F);
    const LAS int* tstart = (const LAS int*)(F.lds + TS_OFF); const LAS int* ecnt = (const LAS int*)(F.lds + EC_OFF);
    LAS int* xtok = (LAS int*)(F.lds + XTOK_OFF);
    MoeGU S{(const char*)(F.ws + WS_R1), (const char*)(F.ws + WS_WGU), tstart, xtok, 2 * tstart[NE], F.G, F.vcu};
    pg8::Unit u;
    for (int ui = 0; ui < 8 && S.next(ui, u); ++ui) {
        if (F.tid < 256) { const int e = u.i2, idx = (u.i0 - tstart[e]) * 256 + F.tid;
            xtok[ui * 256 + F.tid] = idx < ecnt[e] ? ((const int*)(F.ws + WS_ELIST))[(size_t)e * 65536 + idx] : 0; }
    }
    __syncthreads();
    EpiGU E{(bf16*)(F.ws + WS_HID)};
    pg8::gemm_phase<EpiGU, MoeGU, true, true>(F.lds + RING_OFF, D, S, E);
}
__device__ __forceinline__ void p8_down(Frame& F) {
    moe_tables(F);
    const LAS int* tstart = (const LAS int*)(F.lds + TS_OFF);
    MoeDown S{(const char*)(F.ws + WS_HID), (const char*)(F.ws + WS_WD), tstart, 4 * tstart[NE], F.G, F.vcu};
    EpiBf E{(bf16*)(F.ws + WS_YR), D};
    int Kd = DE; asm volatile("" : "+s"(Kd));
    pg8::gemm_phase<EpiBf, MoeDown, true, true>(F.lds + RING_OFF, Kd, S, E);
}

__device__ __forceinline__ void p9_final(Frame& F) {
    const float* MOD = (const float*)(F.ws + WS_MOD);
    const bf16* X1 = (const bf16*)(F.ws + WS_X1);
#if LEVEL >= 4
    LAS int* pst = (LAS int*)(F.lds);
    if (F.tid < NE) { unsigned* cnt = (unsigned*)(F.ws + WS_CTL) + CW_CNT; LAS int* tmp = pst + 64;
        tmp[F.tid] = (int)((__hip_atomic_load(cnt + 64 * F.tid, RLX_AGENT) + 255u) & ~255u);
        LDS_WAIT();
        int acc = 0;
        for (int k = 0; k < NE; ++k) { const int t = tmp[k]; acc += (k < F.tid) ? t : 0; }
        pst[F.tid] = acc; }
    __syncthreads();
    const bf16* YR = (const bf16*)(F.ws + WS_YR);
#endif
    for (int gw = F.vcu * NWAVES + F.wave; gw < T / 16; gw += F.G * NWAVES) {
    const int m0 = gw * 16, b = m0 >> 11;
    f32x4 g2[4], lg[4], lb[4];
#pragma unroll
    for (int j = 0; j < 4; ++j) { const int co = 256 * j + 4 * F.lane; g2[j] = *(const f32x4*)(MOD + b * 6144 + 5 * D + co); lg[j] = *(const f32x4*)(F.ln2_g + co); lb[j] = *(const f32x4*)(F.ln2_b + co); }
#if LEVEL >= 4
    int slv = 0; float ggv = 0.f;
    if (F.lane < 32) { const int ee = ((const int*)(F.ws + WS_TOKE))[m0 * 2 + F.lane], rr = ((const int*)(F.ws + WS_TOKR))[m0 * 2 + F.lane]; ggv = ((const float*)(F.ws + WS_TOKG))[m0 * 2 + F.lane]; slv = pst[ee] + rr; }
#endif
    for (int r = 0; r < 16; ++r) {
        const int m = m0 + r;
        const GAS v2u* xr = (const GAS v2u*)(X1 + (size_t)m * D) + F.lane;
        f32x4 v[4]; float s = 0.f;
#if LEVEL >= 4
        const int s0 = __builtin_amdgcn_readlane(slv, 2 * r), s1 = __builtin_amdgcn_readlane(slv, 2 * r + 1);
        const float ga = __builtin_bit_cast(float, __builtin_amdgcn_readlane(__builtin_bit_cast(int, ggv), 2 * r)), gb = __builtin_bit_cast(float, __builtin_amdgcn_readlane(__builtin_bit_cast(int, ggv), 2 * r + 1));
        const GAS v2u* y0 = (const GAS v2u*)(YR + (size_t)s0 * D) + F.lane; const GAS v2u* y1 = (const GAS v2u*)(YR + (size_t)s1 * D) + F.lane;
#endif
#pragma unroll
        for (int j = 0; j < 4; ++j) { const v2u xw = xr[64 * j]; const f32x4 xv = (f32x4){bflo(xw.x), bfhi(xw.x), bflo(xw.y), bfhi(xw.y)};
#if LEVEL >= 4
            const v2u a = y0[64 * j], c = y1[64 * j];
            const f32x4 f = (f32x4){bflo(a.x), bfhi(a.x), bflo(a.y), bfhi(a.y)} * ga + (f32x4){bflo(c.x), bfhi(c.x), bflo(c.y), bfhi(c.y)} * gb;
            v[j] = xv * ALPHA + g2[j] * f;
#else
            v[j] = xv * ALPHA;
#endif
            s += (v[j].x + v[j].y) + (v[j].z + v[j].w); }
        const float mean = wave_sum(s) * (1.f / D); float s2 = 0.f;
#pragma unroll
        for (int j = 0; j < 4; ++j) { v[j] = v[j] - mean; s2 += (v[j].x * v[j].x + v[j].y * v[j].y) + (v[j].z * v[j].z + v[j].w * v[j].w); }
        const float rstd = __builtin_amdgcn_rsqf(wave_sum(s2) * (1.f / D) + LN_EPS);
        GAS f32x4* orow = (GAS f32x4*)(F.out + (size_t)m * D) + F.lane;
#pragma unroll
        for (int j = 0; j < 4; ++j) orow[64 * j] = v[j] * rstd * lg[j] + lb[j];
    }
    (void)g2;
    }
}

constexpr int NPHASE = 10;
struct Args { const float* in[23]; float* out; unsigned char* ws; int ph_lo, ph_hi, flags, pad; };
__global__ void __launch_bounds__(NTHR, 2) fwd_kernel(Args args) {
    extern __shared__ __attribute__((aligned(16))) unsigned char lds[];
    Frame F;
    F.lds = (LAS unsigned char*)lds;
    F.tid = threadIdx.x; F.lane = F.tid & 63; F.wave = __builtin_amdgcn_readfirstlane(F.tid >> 6);
    F.G = gridDim.x; { const int bx = blockIdx.x; F.vcu = (F.G % 8 == 0) ? (bx % 8) * (F.G / 8) + bx / 8 : bx; }
    F.x = args.in[0]; F.c = args.in[1]; F.w_ada = args.in[2]; F.b_ada = args.in[3]; F.w_in = args.in[4]; F.conv_w = args.in[5]; F.conv_norm_w = args.in[6];
    F.dn_conv_w = args.in[7]; F.dn_A_log = args.in[8]; F.dn_dt_bias = args.in[9]; F.dn_norm_w = args.in[10]; F.w_out = args.in[11]; F.ln1_g = args.in[12]; F.ln1_b = args.in[13];
    F.w_grp = args.in[14]; F.b_grp = args.in[15]; F.w_exp = args.in[16]; F.b_exp = args.in[17]; F.w_gate = args.in[18]; F.w_up = args.in[19]; F.w_down = args.in[20];
    F.ln2_g = args.in[21]; F.ln2_b = args.in[22]; F.out = args.out; F.ws = args.ws; F.flags = args.flags;
    volatile LAS unsigned* MISC = (volatile LAS unsigned*)(F.lds + MISC_OFF);
    for (int u = F.tid; u < (LDS_BYTES - LDSCTL_OFF) / 4; u += NTHR) ((LAS unsigned*)(F.lds + LDSCTL_OFF))[u] = 0u;
    __syncthreads();
    XcdBarrier bar; bar.bar = (unsigned*)(F.ws + WS_CTL) + CW_BAR; bar.x = 0; bar.st = nullptr;
    const int lo = args.ph_lo, hi = args.ph_hi;
    if (hi - lo > 1) bar = xcd_barrier_post((unsigned*)(F.ws + WS_CTL) + CW_BAR, MISC + 8);
#define IN(k) (lo <= (k) && (k) < hi)
#define SEAM(k) do { if (IN(k) && IN((k) + 1)) xcd_barrier(bar); } while (0)
    constexpr int reps[NPHASE] = REPS;
#define REPEAT(k) for (int rep_ = 0; rep_ < reps[k]; ++rep_, (rep_ < reps[k] ? xcd_barrier(bar) : (void)0))

    if (IN(0)) REPEAT(0) { p0_prologue(F); } SEAM(0);
    if (IN(1)) REPEAT(1) { p1_modulate(F); } SEAM(1);
    if (IN(2)) REPEAT(2) {
#if LEVEL >= 2
        pg8::DenseOrder S; S.init(F.ws + WS_R1, F.ws + WS_WIN, T, NMAIN, D, F.G, (int)blockIdx.x);
        EpiP E{F.ws};
        pg8::gemm_phase<EpiP, pg8::DenseOrder, true, true>(F.lds + RING_OFF, D, S, E);
#endif
    } SEAM(2);
    if (IN(3)) REPEAT(3) {
#if LEVEL == 2
        p3a_convmix(F, F.vcu * NWAVES + F.wave, F.G * NWAVES);
#endif
#if LEVEL == 2
        zero_ydelta(F);
#endif
#if LEVEL >= 3 && !defined(NO_PRE)
        dn_pre(F);
#endif
#ifdef EXP_DELAY
        { const unsigned long long t0 = __builtin_amdgcn_s_memrealtime(); while (__builtin_amdgcn_s_memrealtime() - t0 < 60000ull) __builtin_amdgcn_s_sleep(16); }
#endif
    } SEAM(3);
    if (IN(4)) REPEAT(4) {
#if LEVEL >= 3 && !defined(NO_SCAN)
        if ((int)blockIdx.x < NB * NH) dn_scan(F);
        else if (F.G > NB * NH) {
            p3a_convmix(F, ((int)blockIdx.x - NB * NH) * NWAVES + F.wave, (F.G - NB * NH) * NWAVES);
            weight_copies(F, W_ITEMS_IN, W_ITEMS_ALL, ((int)blockIdx.x - NB * NH) * NWAVES + F.wave, (F.G - NB * NH) * NWAVES);
        }
#endif
    } SEAM(4);
    if (IN(5)) REPEAT(5) {
#if LEVEL >= 2
        pg8::DenseOrder S; S.init(F.ws + WS_R1, F.ws + WS_WOUT, T, D, D, F.G, (int)blockIdx.x);
        EpiBf E{(bf16*)(F.ws + WS_MIX), D};
        pg8::gemm_phase<EpiBf, pg8::DenseOrder, true, true>(F.lds + RING_OFF, D, S, E);
#endif
    } SEAM(5);
    if (IN(6)) REPEAT(6) { p5_ln1_router(F); } SEAM(6);
    if (IN(7)) REPEAT(7) {
#if LEVEL >= 4
        p7_gateup(F);
#endif
    } SEAM(7);
    if (IN(8)) REPEAT(8) {
#if LEVEL >= 4
        p8_down(F);
#endif
    } SEAM(8);
    if (IN(9)) REPEAT(9) { p9_final(F); }
    if (IN(10)) { p3a_convmix(F, F.vcu * NWAVES + F.wave, F.G * NWAVES); }
    if (IN(11)) { if ((int)blockIdx.x < NB * NH) dn_scan(F); }
    if (IN(12)) { if ((int)blockIdx.x >= NB * NH) p3a_convmix(F, ((int)blockIdx.x - NB * NH) * NWAVES + F.wave, (F.G - NB * NH) * NWAVES); }
#undef IN
#undef SEAM
}

extern "C" void kernel_launch(void* const* d_in, const int* in_sizes, int n_in, void* d_out, int out_size, void* d_ws, size_t ws_size, hipStream_t stream) {
    static int grid = 0;
    if (grid == 0) {
        if (n_in != 23 || in_sizes[0] != T * D || out_size != T * D || ws_size < WS_END) { fprintf(stderr, "kernel_launch: unexpected shapes (n_in %d, in0 %d, out %d, ws %zu)\n", n_in, n_in > 0 ? in_sizes[0] : -1, out_size, ws_size); grid = -1; return; }
        int dev = 0, cus = 0, per_cu = 0;
        if (hipGetDevice(&dev) != hipSuccess || hipDeviceGetAttribute(&cus, hipDeviceAttributeMultiprocessorCount, dev) != hipSuccess) { grid = -1; return; }
        if (hipFuncSetAttribute((const void*)fwd_kernel, hipFuncAttributeMaxDynamicSharedMemorySize, LDS_BYTES) != hipSuccess) { fprintf(stderr, "kernel_launch: hipFuncSetAttribute failed\n"); grid = -1; return; }
        if (hipOccupancyMaxActiveBlocksPerMultiprocessor(&per_cu, (const void*)fwd_kernel, NTHR, LDS_BYTES) != hipSuccess || per_cu < 1) fprintf(stderr, "kernel_launch: occupancy query says %d\n", per_cu);
        (void)hipGetLastError();
        grid = cus;
        if (grid != 256) fprintf(stderr, "kernel_launch: %d CUs (built for 256)\n", grid);
    }
    if (grid < 0) return;
    if (hipMemsetAsync((char*)d_ws + WS_CTL, 0, CTL_ZERO_BYTES, stream) != hipSuccess) return;
    Args a{};
    for (int i = 0; i < 23; ++i) a.in[i] = (const float*)d_in[i];
    a.out = (float*)d_out; a.ws = (unsigned char*)d_ws;
#if MK_ONE_LAUNCH
    a.ph_lo = 0; a.ph_hi = NPHASE;
    hipLaunchKernelGGL(fwd_kernel, dim3(grid), dim3(NTHR), LDS_BYTES, stream, a);
#ifdef PROBE_PHASE
    a.flags = PROBE_FLAGS;
    for (int r = 0; r < PROBE_REP; ++r) { a.ph_lo = PROBE_PHASE; a.ph_hi = PROBE_PHASE + 1; hipLaunchKernelGGL(fwd_kernel, dim3(grid), dim3(NTHR), LDS_BYTES, stream, a); }
#endif
#else
    for (int p = 0; p < NPHASE; ++p) { a.ph_lo = p; a.ph_hi = p + 1; hipLaunchKernelGGL(fwd_kernel, dim3(grid), dim3(NTHR), LDS_BYTES, stream, a); }
#endif
}
```
